# Optimizing an MI355X kernel written in HIP

```python
import jax, jax.numpy as jnp
from jax import lax
import numpy as np

D_MODEL = 1024
BATCH = 32
SEQ = 256
DEPTH = 4
DEC_BATCH = 2
DEC_SEQ = 2048
PAST_LEN = 512

GRID_W = 64
HEAD_DIM = 64
N_HEADS = 8
N_KV_HEADS = 2
ATTN_WIDTH = N_HEADS * HEAD_DIM
KV_WIDTH = N_KV_HEADS * HEAD_DIM
POOL_WIDTH = D_MODEL - ATTN_WIDTH
POOL_WINDOWS = (2, 4, 8, 16)
N_POOL_GROUPS = 4
POOL_GROUP_DIM = POOL_WIDTH // N_POOL_GROUPS
IN_WIDTH = ATTN_WIDTH + 2 * KV_WIDTH + POOL_WIDTH
D_FF = 2816
CONV_WIDTH = 3
Q_BLOCK = 128
ROPE_THETA = 10000.0
EPS = 1e-6
N_MOD = 6

kernel_name = 'hybrid_attn_pool_diffusion_trunk'


def rms_norm(x, g):
    xf = x.astype(jnp.float32)
    y = xf * lax.rsqrt(jnp.mean(xf * xf, axis=-1, keepdims=True) + EPS)
    return (y * g.astype(jnp.float32)).astype(x.dtype)


def modulation(cond, w_mod, b_mod):
    m = jax.nn.silu(cond) @ w_mod + b_mod
    return jnp.split(m[:, None, :], N_MOD, axis=-1)


def axial_rope_tables(n_tokens):
    t = jnp.arange(n_tokens)
    row = (t // GRID_W).astype(jnp.float32)
    col = (t % GRID_W).astype(jnp.float32)
    n_freq = HEAD_DIM // 4
    inv = ROPE_THETA ** (-jnp.arange(n_freq, dtype=jnp.float32) / n_freq)
    ang = jnp.concatenate([row[:, None] * inv, col[:, None] * inv], axis=-1)
    return jnp.cos(ang), jnp.sin(ang)


def apply_axial_rope(x, cos, sin):
    b, l, h, d = x.shape
    xf = x.astype(jnp.float32).reshape(b, l, h, 2, 2, d // 4)
    x1, x2 = xf[..., 0, :], xf[..., 1, :]
    c = cos.reshape(l, 1, 2, d // 4)
    s = sin.reshape(l, 1, 2, d // 4)
    out = jnp.stack([x1 * c - x2 * s, x1 * s + x2 * c], axis=-2)
    return out.reshape(b, l, h, d).astype(x.dtype)


def block_attention(q, k, v):
    b, l, h, d = q.shape
    n_blk = l // Q_BLOCK
    grp = h // N_KV_HEADS
    qb = q.reshape(b, n_blk, Q_BLOCK, N_KV_HEADS, grp, d).transpose(1, 0, 2, 3, 4, 5)
    kf = k.astype(jnp.float32)
    vf = v.astype(jnp.float32)
    scale = d ** -0.5

    def one_block(qi):
        s = jnp.einsum('bqkgd,bskd->bkgqs', qi.astype(jnp.float32), kf) * scale
        p = jax.nn.softmax(s, axis=-1)
        return jnp.einsum('bkgqs,bskd->bqkgd', p, vf).astype(q.dtype)

    ob = lax.map(one_block, qb)
    return ob.transpose(1, 0, 2, 3, 4, 5).reshape(b, l, h * d)


def pool_mixer(u, w_pool, pool_scale):
    b, l, _ = u.shape
    ug = u.astype(jnp.float32).reshape(b, l, N_POOL_GROUPS, POOL_GROUP_DIM)
    csum = jnp.pad(jnp.cumsum(ug, axis=1), ((0, 0), (1, 0), (0, 0), (0, 0)))
    t = jnp.arange(l)
    outs = []
    for gi, w in enumerate(POOL_WINDOWS):
        lo = jnp.clip(t - w // 2, 0, l)
        hi = jnp.clip(t + (w - w // 2), 0, l)
        total = csum[:, hi, gi] - csum[:, lo, gi]
        cnt = (hi - lo).astype(jnp.float32)[None, :, None]
        outs.append(total / cnt - ug[:, :, gi])
    pooled = jnp.stack(outs, axis=2)
    mixed = jnp.einsum('blgc,gcd->blgd', pooled, w_pool.astype(jnp.float32))
    return (mixed.reshape(b, l, POOL_WIDTH) * pool_scale).astype(u.dtype)


def conv_ffn(h, w_up, conv_w, conv_b, w_down):
    z = h @ w_up
    zp = jnp.pad(z, ((0, 0), (1, 1), (0, 0)))
    z = zp[:, :-2] * conv_w[0] + zp[:, 1:-1] * conv_w[1] + zp[:, 2:] * conv_w[2] + conv_b
    a, g = jnp.split(z, 2, axis=-1)
    return (jax.nn.silu(a) * g) @ w_down


def mixer_projections(h, w_in, q_norm_g, k_norm_g):
    b, l, _ = h.shape
    proj = h @ w_in
    q, k, v, u = jnp.split(proj, [ATTN_WIDTH, ATTN_WIDTH + KV_WIDTH, ATTN_WIDTH + 2 * KV_WIDTH], axis=-1)
    q = rms_norm(q.reshape(b, l, N_HEADS, HEAD_DIM), q_norm_g)
    k = rms_norm(k.reshape(b, l, N_KV_HEADS, HEAD_DIM), k_norm_g)
    v = v.reshape(b, l, N_KV_HEADS, HEAD_DIM)
    return q, k, v, u


def trunk_layer(x, cond, ctx_k, ctx_v, p):
    sh1, sc1, gt1, sh2, sc2, gt2 = modulation(cond, p['w_mod'], p['b_mod'])
    h = rms_norm(x, p['norm1_g']) * (1.0 + sc1) + sh1
    q, k, v, u = mixer_projections(h, p['w_in'], p['q_norm_g'], p['k_norm_g'])
    if ctx_k is None:
        attn = block_attention(q, k, v)
        new_k, new_v = k, v
    else:
        cos, sin = axial_rope_tables(x.shape[1])
        q = apply_axial_rope(q, cos, sin)
        k = apply_axial_rope(k, cos, sin)
        keys = jnp.concatenate([ctx_k.astype(k.dtype), k], axis=1)
        vals = jnp.concatenate([ctx_v.astype(v.dtype), v], axis=1)
        attn = block_attention(q, keys, vals)
        new_k, new_v = None, None
    pooled = pool_mixer(u, p['w_pool'], p['pool_scale'])
    mix = jnp.concatenate([attn, pooled.astype(attn.dtype)], axis=-1) @ p['w_out']
    x = x + gt1 * mix
    h2 = rms_norm(x, p['norm2_g']) * (1.0 + sc2) + sh2
    x = x + gt2 * conv_ffn(h2, p['w_up'], p['conv_w'], p['conv_b'], p['w_down'])
    return x, new_k, new_v


def setup_inputs(seed: int = 0) -> dict:
    key = jax.random.key(seed)
    ks = jax.random.split(key, 24)
    nrm = jax.random.normal
    f32 = jnp.float32
    d = D_MODEL
    return {
        'x_prompt': nrm(ks[0], (BATCH, SEQ, d), f32),
        'x_sample': nrm(ks[1], (DEC_BATCH, DEC_SEQ, d), f32),
        'cache_k': nrm(ks[2], (DEC_BATCH, DEPTH, PAST_LEN, N_KV_HEADS, HEAD_DIM), f32),
        'cache_v': nrm(ks[3], (DEC_BATCH, DEPTH, PAST_LEN, N_KV_HEADS, HEAD_DIM), f32),
        'c': nrm(ks[4], (DEC_BATCH, d), f32),
        'c_ctx': nrm(ks[5], (d,), f32),
        'w_mod': nrm(ks[6], (DEPTH, d, N_MOD * d), f32) * (0.5 * d ** -0.5),
        'b_mod': nrm(ks[7], (DEPTH, N_MOD * d), f32) * 0.01,
        'norm1_g': 1.0 + 0.05 * nrm(ks[8], (DEPTH, d), f32),
        'w_in': nrm(ks[9], (DEPTH, d, IN_WIDTH), f32) * d ** -0.5,
        'q_norm_g': 1.0 + 0.05 * nrm(ks[10], (DEPTH, HEAD_DIM), f32),
        'k_norm_g': 1.0 + 0.05 * nrm(ks[11], (DEPTH, HEAD_DIM), f32),
        'w_pool': nrm(ks[12], (DEPTH, N_POOL_GROUPS, POOL_GROUP_DIM, POOL_GROUP_DIM), f32) * POOL_GROUP_DIM ** -0.5,
        'pool_scale': 1.0 + 0.05 * nrm(ks[13], (DEPTH, POOL_WIDTH), f32),
        'w_out': nrm(ks[14], (DEPTH, d, d), f32) * d ** -0.5,
        'norm2_g': 1.0 + 0.05 * nrm(ks[15], (DEPTH, d), f32),
        'w_up': nrm(ks[16], (DEPTH, d, 2 * D_FF), f32) * d ** -0.5,
        'conv_w': nrm(ks[17], (DEPTH, CONV_WIDTH, 2 * D_FF), f32) * CONV_WIDTH ** -0.5,
        'conv_b': nrm(ks[18], (DEPTH, 2 * D_FF), f32) * 0.01,
        'w_down': nrm(ks[19], (DEPTH, D_FF, d), f32) * D_FF ** -0.5,
        'final_norm_g': 1.0 + 0.05 * nrm(ks[20], (d,), f32),
    }


def reference(x_prompt, x_sample, cache_k, cache_v, c, c_ctx, w_mod, b_mod, norm1_g, w_in,
              q_norm_g, k_norm_g, w_pool, pool_scale, w_out, norm2_g, w_up, conv_w, conv_b,
              w_down, final_norm_g):
    cond_ctx = c_ctx[None, :]
    xp = x_prompt
    xs = x_sample
    ks_out = []
    vs_out = []
    for i in range(DEPTH):
        p = {'w_mod': w_mod[i], 'b_mod': b_mod[i], 'norm1_g': norm1_g[i], 'w_in': w_in[i],
             'q_norm_g': q_norm_g[i], 'k_norm_g': k_norm_g[i], 'w_pool': w_pool[i],
             'pool_scale': pool_scale[i], 'w_out': w_out[i], 'norm2_g': norm2_g[i],
             'w_up': w_up[i], 'conv_w': conv_w[i], 'conv_b': conv_b[i], 'w_down': w_down[i]}
        xp, k_i, v_i = trunk_layer(xp, cond_ctx, None, None, p)
        ks_out.append(k_i)
        vs_out.append(v_i)
        xs, _, _ = trunk_layer(xs, c, cache_k[:, i], cache_v[:, i], p)
    y_prompt = rms_norm(xp, final_norm_g)
    y_sample = rms_norm(xs, final_norm_g)
    new_cache_k = jnp.stack(ks_out, axis=1)
    new_cache_v = jnp.stack(vs_out, axis=1)
    return (y_prompt, y_sample, new_cache_k, new_cache_v)
```

```cpp
#include <hip/hip_runtime.h>
#include <hip/hip_cooperative_groups.h>
#include <cstdio>
#include <cstdint>
namespace cg = cooperative_groups;
#define MK_MULTI 0
namespace pg8 {
#define PG8_LAS __attribute__((address_space(3)))
typedef unsigned short bf16_t;
typedef short bf16x8 __attribute__((ext_vector_type(8)));
typedef float f32x4 __attribute__((ext_vector_type(4)));
typedef unsigned u32x4 __attribute__((ext_vector_type(4)));
constexpr int BM = 256, BK = 64, HALF = 128, HTB = HALF * BK * 2  , STAGE_BYTES = 8 * HTB, NXCD = 8, WGM = 6;

__host__ __device__ __forceinline__ int lds_byte(int r, int c) { const int st = (r >> 4) * 2 + (c >> 5), rr = r & 15, cc = c & 31, ob = rr * 64 + cc * 2; return st * 1024 + (ob ^ (((ob >> 9) & 1) << 5)); }
__host__ __device__ __forceinline__ void stage_rc(int b, int& R, int& C) { const int st = b / 1024, sb = b % 1024, swz = sb ^ (((sb >> 9) & 1) << 5); R = (st >> 1) * 16 + swz / 64; C = (st & 1) * 32 + (swz % 64) / 2; }
__host__ __device__ __forceinline__ int perm32(int rho) { const int n = rho >> 4, i = rho & 15; return 8 * (i >> 2) + 4 * n + (i & 3); }

struct Unit { int pm, pn; };
struct Gemm { const bf16_t* A; const bf16_t* Bt; int M, N, K; };

struct StaticOrder {
    int nM, nN, nwg, G, c;
    __host__ __device__ void init(int M, int N, int G_, int c_) { nM = M / BM; nN = N / BM; nwg = nM * nN; G = G_; c = c_; }
    __host__ __device__ bool next(int i, Unit& u) const {
        const long L = (long)i * G + c; if (L >= nwg) return false;
        int wgid = (int)L; { const int q = nwg / NXCD, r = nwg % NXCD, xcd = wgid % NXCD, off = wgid / NXCD; wgid = (xcd < r ? xcd * (q + 1) : r * (q + 1) + (xcd - r) * q) + off; }
        const int nig = WGM * nN, gid = wgid / nig, fm = gid * WGM, gsz = (nM - fm) < WGM ? (nM - fm) : WGM;
        u.pm = fm + ((wgid % nig) % gsz); u.pn = (wgid % nig) / gsz; return true;
    }
    __device__ __forceinline__ void a_ready(const Unit&) const {}
    __device__ __forceinline__ void done(const Unit&) const {}
};

__device__ __forceinline__ unsigned cvt_pk_bf16(float lo, float hi) { unsigned r; asm volatile("v_cvt_pk_bf16_f32 %0, %1, %2" : "=v"(r) : "v"(lo), "v"(hi)); return r; }
typedef float f32x2 __attribute__((ext_vector_type(2)));
__device__ __forceinline__ f32x2 gelu_pk(f32x2 v) {
    const f32x2 av = __builtin_elementwise_abs(v), d = av * 0.2316418882f + 1.0f;
    f32x2 t; t.x = __builtin_amdgcn_rcpf(d.x); t.y = __builtin_amdgcn_rcpf(d.y);
    f32x2 q = t * 0.5307027145f + (-0.7265760135f); q = q * t + 0.7107068705f; q = q * t + (-0.142248368f); q = q * t + 0.127414796f; q = q * t;
    const f32x2 s = (v * v) * (-0.72134752044f);
    f32x2 e; e.x = __builtin_amdgcn_exp2f(s.x); e.y = __builtin_amdgcn_exp2f(s.y);
    const f32x2 m = v * (q * e), r = v - m;
    f32x2 o; o.x = v.x < 0.f ? m.x : r.x; o.y = v.y < 0.f ? m.y : r.y; return o;
}

template <int ACT  > struct EpiBf16 {
    static constexpr bool PERM = true, AFTER_DRAIN = false; static_assert(ACT == 0 || ACT == 1, "EpiBf16: ACT is 0 (none) or 1 (gelu_pk)");
    bf16_t* O; int ldc; const float* bias; int split_cols; size_t split_stride; float scale0;
    __device__ __forceinline__ void operator()(const f32x4 (&acc)[2][2][4][2], const Unit& u, int wr, int wc, int fr, int fq) const {
        const int row0 = u.pm * BM + wr * 64 + fr; int colt = u.pn * BM; bf16_t* base = O;
        float sc = 1.f; if (split_cols) { const int t = colt / split_cols; base += (size_t)t * split_stride; colt -= t * split_cols; if (t == 0) sc = scale0; }
        const int col0 = colt + wc * 32 + 8 * fq, bcol0 = u.pn * BM + wc * 32 + 8 * fq;
        f32x4 bv[2][2];
#pragma unroll
        for (int bj = 0; bj < 2; ++bj)
#pragma unroll
            for (int n = 0; n < 2; ++n) bv[bj][n] = bias ? *(const f32x4*)(bias + bcol0 + bj * HALF + 4 * n) : (f32x4){0.f, 0.f, 0.f, 0.f};
#pragma unroll
        for (int ai = 0; ai < 2; ++ai)
#pragma unroll
            for (int m = 0; m < 4; ++m) { bf16_t* rowp = base + (size_t)(row0 + ai * HALF + m * 16) * ldc + col0;
#pragma unroll
                for (int bj = 0; bj < 2; ++bj) { f32x4 v0 = acc[ai][bj][m][0] + bv[bj][0], v1 = acc[ai][bj][m][1] + bv[bj][1];
                    if (ACT == 1) { f32x2 a = gelu_pk((f32x2){v0[0], v0[1]}), b = gelu_pk((f32x2){v0[2], v0[3]}), c = gelu_pk((f32x2){v1[0], v1[1]}), d = gelu_pk((f32x2){v1[2], v1[3]});
                        v0 = (f32x4){a.x, a.y, b.x, b.y}; v1 = (f32x4){c.x, c.y, d.x, d.y}; }
                    v0 = v0 * sc; v1 = v1 * sc; u32x4 w; w.x = cvt_pk_bf16(v0[0], v0[1]); w.y = cvt_pk_bf16(v0[2], v0[3]); w.z = cvt_pk_bf16(v1[0], v1[1]); w.w = cvt_pk_bf16(v1[2], v1[3]);
                    *(u32x4*)(rowp + bj * HALF) = w; } }
    }
};
template <class Epi, class Sched, bool ALIGN_EPI = false, bool SP2 = false>
__device__ __forceinline__ void gemm_phase(PG8_LAS unsigned char* lds, const Gemm g, const Sched& S, const Epi& E) {
    int tid_ = threadIdx.x; asm volatile("" : "+v"(tid_));
    const int tid = tid_, wid = __builtin_amdgcn_readfirstlane(tid >> 6), lane = tid & 63, wr = wid >> 2, wc = wid & 3, fr = lane & 15, fq = lane >> 4;
    const int K = g.K, nt = K / BK;
    unsigned voffA[2], voffB[2];
#pragma unroll
    for (int i = 0; i < 2; ++i) { int R, C; stage_rc(tid * 16 + i * 8192, R, C); const int Rb = Epi::PERM ? ((R & ~31) + perm32(R & 31)) : R;
        voffA[i] = (unsigned)(R * K + C) * 2u; voffB[i] = (unsigned)(Rb * K + C) * 2u; }
    const size_t kstep = (size_t)(BK * 2);
    const size_t hstep = (size_t)HALF * K * 2;
    const size_t tstep = 2 * hstep;
    const unsigned ldsw = (unsigned)wid * 1024u;
    const int aoff = lds_byte(wr * 64 + fr, fq * 8), boff = lds_byte(wc * 32 + fr, fq * 8);
#define PG8_SA(b, h) (((b) * 2 + (h)) * HTB)
#define PG8_SB(b, h) ((4 + (b) * 2 + (h)) * HTB)
#define PG8_STAGE(bufoff, gbase, voff) do { _Pragma("unroll") for (int _i = 0; _i < 2; ++_i) \
        __builtin_amdgcn_global_load_lds((const unsigned*)((const char*)(gbase) + (voff)[_i]), (PG8_LAS unsigned*)(lds + (bufoff) + ldsw + _i * 8192), 16, 0, 0); } while (0)
#define PG8_LDA(dst, b, h) do { _Pragma("unroll") for (int m = 0; m < 4; ++m) _Pragma("unroll") for (int k = 0; k < 2; ++k) dst[m][k] = *(const PG8_LAS bf16x8*)(lds + PG8_SA(b, h) + aoff + m * 2048 + k * 1024); } while (0)
#define PG8_LDB(dst, b, h) do { _Pragma("unroll") for (int n = 0; n < 2; ++n) _Pragma("unroll") for (int k = 0; k < 2; ++k) dst[n][k] = *(const PG8_LAS bf16x8*)(lds + PG8_SB(b, h) + boff + n * 2048 + k * 1024); } while (0)
#define PG8_MMA(ai, bj, At, Bt) do { __builtin_amdgcn_s_setprio(1); _Pragma("unroll") for (int m = 0; m < 4; ++m) _Pragma("unroll") for (int n = 0; n < 2; ++n) _Pragma("unroll") for (int k = 0; k < 2; ++k) \
        acc[ai][bj][m][n] = __builtin_amdgcn_mfma_f32_16x16x32_bf16(Bt[n][k], At[m][k], acc[ai][bj][m][n], 0, 0, 0); __builtin_amdgcn_s_setprio(0); } while (0)
#define PG8_WAIT_V(n) asm volatile("s_waitcnt vmcnt(" #n ")" ::: "memory")
#define PG8_WAIT_L(n) asm volatile("s_waitcnt lgkmcnt(" #n ")" ::: "memory")
#define PG8_BAR __builtin_amdgcn_s_barrier()
#define PG8_SCHED __builtin_amdgcn_sched_barrier(0)
    Unit cur, nxt; int ui = 0;
    if (!S.next(0, cur)) return;
    f32x4 acc[2][2][4][2];
#pragma unroll
    for (int a = 0; a < 2; ++a)
#pragma unroll
        for (int b = 0; b < 2; ++b)
#pragma unroll
            for (int m = 0; m < 4; ++m)
#pragma unroll
                for (int n = 0; n < 2; ++n) acc[a][b][m][n] = (f32x4){0.f, 0.f, 0.f, 0.f};
    bf16x8 At[4][2], B0[2][2], B1[2][2];
    const char* cA = (const char*)g.A + (size_t)cur.pm * tstep; const char* cB = (const char*)g.Bt + (size_t)cur.pn * tstep;
    S.a_ready(cur);
    if constexpr (SP2) {
        PG8_STAGE(PG8_SB(0, 0), cB, voffB); PG8_STAGE(PG8_SB(0, 1), cB + hstep, voffB); PG8_STAGE(PG8_SA(0, 0), cA, voffA); PG8_STAGE(PG8_SA(0, 1), cA + hstep, voffA);
        if (wr == 1) PG8_BAR;
        PG8_WAIT_V(2); PG8_BAR;
        PG8_STAGE(PG8_SB(1, 0), cB + kstep, voffB); PG8_STAGE(PG8_SA(1, 0), cA + kstep, voffA); PG8_STAGE(PG8_SB(1, 1), cB + hstep + kstep, voffB);
        PG8_WAIT_V(6); PG8_BAR;
    } else {
        PG8_STAGE(PG8_SB(0, 0), cB, voffB); PG8_STAGE(PG8_SA(0, 0), cA, voffA); PG8_STAGE(PG8_SB(0, 1), cB + hstep, voffB); PG8_STAGE(PG8_SA(0, 1), cA + hstep, voffA);
        if (wr == 1) PG8_BAR;
        PG8_WAIT_V(4); PG8_BAR;
        PG8_STAGE(PG8_SB(1, 0), cB + kstep, voffB); PG8_STAGE(PG8_SA(1, 0), cA + kstep, voffA); PG8_STAGE(PG8_SB(1, 1), cB + hstep + kstep, voffB);
        PG8_WAIT_V(6); PG8_BAR;
    }
    for (;;) {
        const bool has_next = S.next(ui + 1, nxt);
        const char* nA = has_next ? (const char*)g.A + (size_t)nxt.pm * tstep : cA; const char* nB = has_next ? (const char*)g.Bt + (size_t)nxt.pn * tstep : cB;
        for (int t = 0; t < nt; t += 2) {
            const bool last = (t == nt - 2);
            const char* a1 = cA + (size_t)(t + 1) * kstep;
            const char* a2 = last ? nA : cA + (size_t)(t + 2) * kstep; const char* b2 = last ? nB : cB + (size_t)(t + 2) * kstep;
            const char* a3 = a2 + kstep; const char* b3 = b2 + kstep;
            if (last && has_next) S.a_ready(nxt);
            if constexpr (SP2) {
            PG8_LDB(B0, 0, 0); PG8_LDB(B1, 0, 1); PG8_SCHED; PG8_LDA(At, 0, 0); PG8_STAGE(PG8_SA(1, 1), a1 + hstep, voffA);
            PG8_WAIT_V(8); PG8_WAIT_L(0); PG8_BAR; PG8_MMA(0, 0, At, B0); PG8_MMA(0, 1, At, B1); PG8_BAR; PG8_SCHED;
            PG8_LDA(At, 0, 1); PG8_STAGE(PG8_SB(0, 0), b2, voffB); PG8_STAGE(PG8_SB(0, 1), b2 + hstep, voffB); PG8_STAGE(PG8_SA(0, 0), a2, voffA);
            PG8_WAIT_V(8); PG8_WAIT_L(0); PG8_BAR; PG8_MMA(1, 0, At, B0); PG8_MMA(1, 1, At, B1); PG8_BAR; PG8_SCHED;
            PG8_LDB(B0, 1, 0); PG8_LDB(B1, 1, 1); PG8_SCHED; PG8_LDA(At, 1, 0); PG8_STAGE(PG8_SA(0, 1), a2 + hstep, voffA);
            PG8_WAIT_V(8); PG8_WAIT_L(0); PG8_BAR; PG8_MMA(0, 0, At, B0); PG8_MMA(0, 1, At, B1); PG8_BAR; PG8_SCHED;
            PG8_LDA(At, 1, 1); PG8_STAGE(PG8_SB(1, 0), b3, voffB); PG8_STAGE(PG8_SB(1, 1), b3 + hstep, voffB); PG8_STAGE(PG8_SA(1, 0), a3, voffA);
            PG8_WAIT_V(8); PG8_WAIT_L(0); PG8_BAR; PG8_MMA(1, 0, At, B0); PG8_MMA(1, 1, At, B1); PG8_BAR; PG8_SCHED;
            } else {
            PG8_LDB(B0, 0, 0); PG8_SCHED; PG8_LDA(At, 0, 0); PG8_STAGE(PG8_SA(1, 1), a1 + hstep, voffA);
            PG8_WAIT_L(8); PG8_BAR; PG8_WAIT_L(0); PG8_MMA(0, 0, At, B0); PG8_BAR; PG8_SCHED;
            PG8_LDB(B1, 0, 1); PG8_STAGE(PG8_SB(0, 0), b2, voffB);
            PG8_BAR; PG8_WAIT_L(0); PG8_MMA(0, 1, At, B1); PG8_BAR;
            PG8_LDA(At, 0, 1); PG8_STAGE(PG8_SA(0, 0), a2, voffA);
            PG8_BAR; PG8_WAIT_L(0); PG8_MMA(1, 0, At, B0); PG8_BAR; PG8_SCHED;
            PG8_STAGE(PG8_SB(0, 1), b2 + hstep, voffB);
            PG8_WAIT_V(6); PG8_BAR; PG8_MMA(1, 1, At, B1); PG8_BAR;
            PG8_LDB(B0, 1, 0); PG8_SCHED; PG8_LDA(At, 1, 0); PG8_STAGE(PG8_SA(0, 1), a2 + hstep, voffA);
            PG8_WAIT_L(8); PG8_BAR; PG8_WAIT_L(0); PG8_MMA(0, 0, At, B0); PG8_BAR; PG8_SCHED;
            PG8_LDB(B1, 1, 1); PG8_STAGE(PG8_SB(1, 0), b3, voffB);
            PG8_BAR; PG8_WAIT_L(0); PG8_MMA(0, 1, At, B1); PG8_BAR;
            PG8_LDA(At, 1, 1); PG8_STAGE(PG8_SA(1, 0), a3, voffA);
            PG8_BAR; PG8_WAIT_L(0); PG8_MMA(1, 0, At, B0); PG8_BAR; PG8_SCHED;
            PG8_STAGE(PG8_SB(1, 1), b3 + hstep, voffB);
            PG8_WAIT_V(6); PG8_BAR; PG8_MMA(1, 1, At, B1); PG8_BAR;
            }
        }
        if constexpr (ALIGN_EPI) { if (wr == 0) PG8_BAR; }
        if constexpr (!Epi::AFTER_DRAIN) { E(acc, cur, wr, wc, fr, fq); S.done(cur); }
        if (!has_next) break;
#pragma unroll
        for (int a = 0; a < 2; ++a)
#pragma unroll
            for (int b = 0; b < 2; ++b)
#pragma unroll
                for (int m = 0; m < 4; ++m)
#pragma unroll
                    for (int n = 0; n < 2; ++n) acc[a][b][m][n] = (f32x4){0.f, 0.f, 0.f, 0.f};
        cur = nxt; cA = nA; cB = nB; ++ui;
        if constexpr (ALIGN_EPI) { if (wr == 1) PG8_BAR; }
    }
    PG8_WAIT_V(0);
    if constexpr (!ALIGN_EPI) { if (wr == 0) PG8_BAR; }
    PG8_BAR;
    if constexpr (Epi::AFTER_DRAIN) { E.fused(acc, cur, wr, wc, fr, fq, lds, wid, lane); S.done(cur); }
#undef PG8_SA
#undef PG8_SB
#undef PG8_STAGE
#undef PG8_LDA
#undef PG8_LDB
#undef PG8_MMA
#undef PG8_WAIT_V
#undef PG8_WAIT_L
#undef PG8_BAR
#undef PG8_SCHED
}
}
#include <hip/hip_bf16.h>
#include <cmath>
namespace attn_body {
using bf16=__hip_bfloat16;
using bf16x8=__attribute__((ext_vector_type(8)))short;
using s16x4=__attribute__((ext_vector_type(4)))short;
using f32x16=__attribute__((ext_vector_type(16)))float;
using u32x4=__attribute__((ext_vector_type(4)))unsigned;
constexpr int D=64,QP=512,KP=128,OP=1024;
constexpr int NW=8,QBLK=32,QB=QBLK*NW,KVBLK=64;
constexpr int ATTN_UNIT_ROWS=QB;
__device__ __forceinline__ int crow(int r,int hi){return (r&3)+8*(r>>2)+4*hi;}
#define SBAR() __builtin_amdgcn_sched_barrier(0)
__device__ __forceinline__ void cmask(f32x16&p0,f32x16&p1,int jb,int qrel,int hi){
  const float NEG=-INFINITY; int kb=64*jb+4*hi;
  #pragma unroll
  for(int r=0;r<16;++r){int kv=kb+(r&3)+8*(r>>2); if(kv>qrel)p0[r]=NEG; if(kv+32>qrel)p1[r]=NEG;}
}

constexpr int NSLOT=3, SLOTB=8192;
constexpr int NVSLOT=4;
constexpr int LDS_K=0, LDS_V=NSLOT*SLOTB, LDS_WS=(NSLOT+NVSLOT)*SLOTB, LDS_OST=LDS_WS+NW*64*4, LDS_BYTES=LDS_OST+NW*4096;
constexpr float C2=0.125f*1.4426950408889634f;
__device__ __forceinline__ void glds16(const void*gsrc,unsigned lds_dst){unsigned keep;
  asm volatile("s_mov_b32 %0, m0\n\ts_mov_b32 m0, %2\n\ts_nop 0\n\tglobal_load_lds_dwordx4 %1, off\n\ts_mov_b32 m0, %0":"=&s"(keep):"v"(gsrc),"s"(lds_dst):"memory");}
__device__ __forceinline__ float max3f(float a,float b,float c){float r;asm("v_max3_f32 %0, %1, %2, %3":"=v"(r):"v"(a),"v"(b),"v"(c));return r;}
__device__ __forceinline__ float max2f(float a,float b){float r;asm("v_max_f32_e32 %0, %1, %2":"=v"(r):"v"(a),"v"(b));return r;}
__device__ __forceinline__ float fadd_s(float a,float b){float r;asm("v_add_f32_e32 %0, %1, %2":"=v"(r):"v"(a),"v"(b));return r;}
__device__ __forceinline__ float fsub_s(float a,float b){float r;asm("v_sub_f32_e32 %0, %1, %2":"=v"(r):"v"(a),"v"(b));return r;}
typedef float f32x2_t __attribute__((ext_vector_type(2))); typedef __bf16 bf16x2_t __attribute__((ext_vector_type(2)));
__device__ __forceinline__ unsigned cvtpk_s(float lo,float hi){f32x2_t v={lo,hi};bf16x2_t b=__builtin_convertvector(v,bf16x2_t);return __builtin_bit_cast(unsigned,b);}
#define WAIT_BAR(N) asm volatile("s_waitcnt vmcnt(" #N ") lgkmcnt(0)\n\ts_barrier":::"memory")

__device__ __forceinline__ void qkt(f32x16&p0,f32x16&p1,const char*Kslot,const bf16x8*qr,const f32x16&negm,int r32,int hi){
  const char*kb=Kslot+hi*1024+r32*16;
  #pragma unroll
  for(int d0=0;d0<4;++d0){
    const bf16x8 b0=*reinterpret_cast<const bf16x8*>(kb+d0*2048);
    const bf16x8 b1=*reinterpret_cast<const bf16x8*>(kb+d0*2048+512);
    if(d0==0){p0=__builtin_amdgcn_mfma_f32_32x32x16_bf16(b0,qr[0],negm,0,0,0);p1=__builtin_amdgcn_mfma_f32_32x32x16_bf16(b1,qr[0],negm,0,0,0);}
    else{p0=__builtin_amdgcn_mfma_f32_32x32x16_bf16(b0,qr[d0],p0,0,0,0);p1=__builtin_amdgcn_mfma_f32_32x32x16_bf16(b1,qr[d0],p1,0,0,0);}}
}
typedef __attribute__((address_space(3))) const char* lds_cptr;
typedef short v4i16_t __attribute__((ext_vector_type(4)));
__device__ __forceinline__ void kload8(bf16x8*kf,lds_cptr kp){
  kf[0]=*(const __attribute__((address_space(3))) bf16x8*)(kp);      kf[1]=*(const __attribute__((address_space(3))) bf16x8*)(kp+512);
  kf[2]=*(const __attribute__((address_space(3))) bf16x8*)(kp+2048); kf[3]=*(const __attribute__((address_space(3))) bf16x8*)(kp+2560);
  kf[4]=*(const __attribute__((address_space(3))) bf16x8*)(kp+4096); kf[5]=*(const __attribute__((address_space(3))) bf16x8*)(kp+4608);
  kf[6]=*(const __attribute__((address_space(3))) bf16x8*)(kp+6144); kf[7]=*(const __attribute__((address_space(3))) bf16x8*)(kp+6656);
}
__device__ __forceinline__ void kload2(bf16x8*kf,lds_cptr kp,int j){ kf[2*j]=*(const __attribute__((address_space(3))) bf16x8*)(kp+j*2048); kf[2*j+1]=*(const __attribute__((address_space(3))) bf16x8*)(kp+j*2048+512); }
__device__ __forceinline__ s16x4 vtr(lds_cptr p){ return __builtin_bit_cast(s16x4,__builtin_amdgcn_ds_read_tr16_b64_v4i16((__attribute__((address_space(3))) v4i16_t*)p)); }
__device__ __forceinline__ float rowmax(const f32x16&p0,const f32x16&p1){
  float a=max3f(p0[0],p0[1],p1[0]),b=max3f(p0[2],p0[3],p1[1]);a=max3f(a,p1[2],p1[3]);
  #pragma unroll
  for(int r=4;r<16;r+=4){a=max3f(a,p0[r],p0[r+1]);b=max3f(b,p0[r+2],p0[r+3]);a=max3f(a,p1[r],p1[r+1]);b=max3f(b,p1[r+2],p1[r+3]);}
  const float m=max2f(a,b);
  auto rr=__builtin_amdgcn_permlane32_swap(__float_as_uint(m),__float_as_uint(m),false,false);
  return max2f(__uint_as_float(rr[0]),__uint_as_float(rr[1]));
}
__device__ __forceinline__ void pv(f32x16*o,int vb,bf16x8 pa0,bf16x8 pa1,bf16x8 pa2,bf16x8 pa3){
  #pragma unroll
  for(int d0=0;d0<2;++d0){s16x4 lo[4],hi[4];
    #pragma unroll
    for(int ks=0;ks<4;++ks){
      asm volatile("ds_read_b64_tr_b16 %0,%1 offset:%c2":"=&v"(lo[ks]):"v"(vb),"i"(d0*4096+ks*1024):"memory");
      asm volatile("ds_read_b64_tr_b16 %0,%1 offset:%c2":"=&v"(hi[ks]):"v"(vb),"i"(d0*4096+ks*1024+512):"memory");}
    asm volatile("s_waitcnt lgkmcnt(0)":::"memory");SBAR();
    #define PK(k) (bf16x8){lo[k][0],lo[k][1],lo[k][2],lo[k][3],hi[k][0],hi[k][1],hi[k][2],hi[k][3]}
    o[d0]=__builtin_amdgcn_mfma_f32_32x32x16_bf16(pa0,PK(0),o[d0],0,0,0);
    o[d0]=__builtin_amdgcn_mfma_f32_32x32x16_bf16(pa1,PK(1),o[d0],0,0,0);
    o[d0]=__builtin_amdgcn_mfma_f32_32x32x16_bf16(pa2,PK(2),o[d0],0,0,0);
    o[d0]=__builtin_amdgcn_mfma_f32_32x32x16_bf16(pa3,PK(3),o[d0],0,0,0);
    #undef PK
  }
}

#ifndef ATTN_STORE16
#define ATTN_STORE16(p,v) (*(u32x4*)(p)=(v))
#endif
template<int THRL> __device__ __forceinline__ void attn_unit(const bf16*Q0,const bf16*__restrict__ Kh,const bf16*__restrict__ Vh,bf16*O0,const int NT,char*shm,const int split,float*part,const float*partner,unsigned*cnt,const int ncomp){
  int tid_=threadIdx.x; asm volatile("":"+v"(tid_));
  const int tid=tid_,lane=tid&63,r32=lane&31,hi=lane>>5; const int wid=__builtin_amdgcn_readfirstlane(tid>>6);
  const bf16*Qw=Q0+(long)(wid*QBLK)*QP;
  const unsigned lds0=(unsigned)(uintptr_t)shm;
  float*wsf=(float*)(shm+LDS_WS)+wid*64;
  const bf16*ksrc=Kh+(long)lane*KP+wid*8;
  const bf16*vsrc=Vh+(long)(16*(wid&3)+(lane>>2))*KP+(wid>>2)*32+(lane&3)*8;
  const unsigned kdst=lds0+LDS_K+wid*1024, vdst=lds0+LDS_V+wid*1024;
  #define DMA_K(t,slot) glds16(ksrc+(long)(t)*KVBLK*KP,(unsigned)__builtin_amdgcn_readfirstlane(kdst+(slot)))
  #define DMA_V(t,slot) glds16(vsrc+(long)(t)*KVBLK*KP,(unsigned)__builtin_amdgcn_readfirstlane(vdst+(slot)))
  const int vb0=(int)(lds0+LDS_V)+((lane>>4)&1)*32+(lane&3)*8+(4*hi+((lane&15)>>2))*64;
  const char*Kbase=shm+LDS_K; bf16x8 kf[8];
  const lds_cptr shm3=(lds_cptr)shm; const lds_cptr kp0=shm3+LDS_K+hi*1024+r32*16; const lds_cptr vp0=shm3+LDS_V+((lane>>4)&1)*32+(lane&3)*8+(4*hi+((lane&15)>>2))*64;
  const bool stream=(ncomp==4);
  if(stream&&wid>=4){
    const int p0=2*(wid-4);
    const bf16*ks0=Kh+(long)lane*KP+p0*8, *ks1=ks0+8;
    const bf16*vs0=Vh+(long)(16*(p0&3)+(lane>>2))*KP+(p0>>2)*32+(lane&3)*8, *vs1=Vh+(long)(16*((p0+1)&3)+(lane>>2))*KP+((p0+1)>>2)*32+(lane&3)*8;
    const unsigned kd0=lds0+LDS_K+p0*1024, vd0=lds0+LDS_V+p0*1024;
    #define SK_(t) do{ const unsigned so_=(unsigned)(((t)%3)*SLOTB); glds16(ks0+(long)(t)*KVBLK*KP,(unsigned)__builtin_amdgcn_readfirstlane(kd0+so_)); glds16(ks1+(long)(t)*KVBLK*KP,(unsigned)__builtin_amdgcn_readfirstlane(kd0+1024+so_)); }while(0)
    #define SV_(t) do{ const unsigned so_=(unsigned)(((t)&3)*SLOTB); glds16(vs0+(long)(t)*KVBLK*KP,(unsigned)__builtin_amdgcn_readfirstlane(vd0+so_)); glds16(vs1+(long)(t)*KVBLK*KP,(unsigned)__builtin_amdgcn_readfirstlane(vd0+1024+so_)); }while(0)
    SK_(0);SV_(0);SK_(1);SV_(1);SK_(2);
    WAIT_BAR(8);
    WAIT_BAR(0);
    SV_(2);SK_(3);
    WAIT_BAR(4);
    for(int t=1;t+1<NT;++t){
      const bool gv=(t+2<NT),gk=(t+3<NT);
      if(gv){SV_(t+2);} if(gk){SK_(t+3);}
      if(gk){WAIT_BAR(4);} else if(gv){WAIT_BAR(2);} else {WAIT_BAR(0);}
    }
    asm volatile("s_waitcnt lgkmcnt(0)\n\ts_barrier":::"memory");
    #undef SK_
    #undef SV_
    return;
  }
  const bool dma_en=!stream;
  const int vwrap=(stream?NVSLOT-1:NSLOT-1)*SLOTB;
  if(dma_en){
  DMA_K(0,0);DMA_V(0,0);DMA_K(1,SLOTB);
  }
  bf16x8 qr[4];
  #pragma unroll
  for(int d0=0;d0<4;++d0)qr[d0]=*reinterpret_cast<const bf16x8*>(&Qw[(long)r32*QP+d0*16+hi*8]);
  float mhat=0.f,l_reg=0.f;f32x16 o[2];o[0]=f32x16{};o[1]=f32x16{};f32x16 negm=f32x16{};asm volatile("":"+v"(negm));
  #define CMASK(P0,P1,t) do{}while(0)
  bool resc=false;
  #define START(P0,P1) do{ const float rm=rowmax(P0,P1); resc=false; \
    { const float dl=rm; mhat=fadd_s(mhat,dl); \
      _Pragma("unroll") for(int r=0;r<16;++r){P0[r]=fsub_s(P0[r],dl);P1[r]=fsub_s(P1[r],dl);} \
      _Pragma("unroll") for(int r=0;r<16;++r)negm[r]=-mhat; asm volatile("":"+v"(negm)); } \
    _Pragma("unroll") for(int r=0;r<16;++r)P0[r]=__builtin_amdgcn_exp2f(P0[r]); }while(0)
  #define RESC() do{ if(resc){ asm volatile("s_waitcnt lgkmcnt(0)":::"memory"); \
      _Pragma("unroll") for(int d_=0;d_<2;++d_) _Pragma("unroll") for(int r=0;r<16;++r)o[d_][r]*=wsf[crow(r,hi)]; } }while(0)
  f32x16 pA0,pA1,pB0,pB1;
  int sl_prev=0,sl_cur=0,sl_next=SLOTB;
  int vs_prev=0,vs_cur=0,vs_next=SLOTB;
  #define ROT() do{sl_prev=sl_cur;sl_cur=sl_next;sl_next=(sl_next==(NSLOT-1)*SLOTB)?0:sl_next+SLOTB; vs_prev=vs_cur;vs_cur=vs_next;vs_next=(vs_next==vwrap)?0:vs_next+SLOTB;}while(0)
  if(dma_en){DMA_K(2,2*SLOTB);}
  WAIT_BAR(3);
  qkt(pA0,pA1,Kbase,qr,negm,r32,hi);asm volatile("s_nop 15\n\ts_nop 7":"+v"(pA0),"+v"(pA1));CMASK(pA0,pA1,0);
  START(pA0,pA1);
  _Pragma("unroll") for(int r=0;r<16;++r)pA1[r]=__builtin_amdgcn_exp2f(pA1[r]);
  WAIT_BAR(0);
  if(dma_en){DMA_K(3,0);DMA_V(1,SLOTB);}
  ROT();
  kload8(kf,kp0+sl_cur);
  WAIT_BAR(2);
  s16x4 vlo[8],vhi[8]; u32x4 pw0,pw1,pw2,pw3;
  #define PKW(P,B) cvtpk_s(P[B],P[B+1])
  #define PAF(k) __builtin_bit_cast(bf16x8,pw##k)
  #define VFR(i) (bf16x8){vlo[i][0],vlo[i][1],vlo[i][2],vlo[i][3],vhi[i][0],vhi[i][1],vhi[i][2],vhi[i][3]}
  #define PIN(x) asm volatile("":"+v"(x))
  #define MX3(a,b,c) __builtin_fmaxf(__builtin_fmaxf((a),(b)),(c))
  #define GAPA(MF,A0,A1,A2,A3,W0,W1,PW) do{ MF; sacc+=A0; sacc+=A1; sacc+=A2; sacc+=A3; PIN(sacc); W0; W1; PIN(PW); SBAR(); }while(0)
  #define EX(v) __builtin_amdgcn_exp2f(v)
  #define GAPB(MF,X,B) do{ MF; X[B]=EX(X[B]); X[B+1]=EX(X[B+1]); X[B+2]=EX(X[B+2]); X[B+3]=EX(X[B+3]); PIN(X); SBAR(); }while(0)
  #define VRD(i) do{ vlo[i]=vtr(vp_+(((i)>>2)*4096+((i)&3)*1024)); vhi[i]=vtr(vp_+(((i)>>2)*4096+((i)&3)*1024+512)); }while(0)
  #define KRD(G,j) do{ if(G){ kload2(kf,kp0+sl_next,j); SBAR(); } }while(0)
  #define STEP(C0,C1,P0,P1,t,GK,GV,GL) do{ SBAR(); \
    const lds_cptr vp_=vp0+vs_prev; \
    VRD(0); SBAR(); float sacc=(P0[0]+P0[1]); \
    GAPA(C0=__builtin_amdgcn_mfma_f32_32x32x16_bf16(kf[0],qr[0],negm,0,0,0), P0[2],P0[3],P0[4],P0[5],     pw0[0]=PKW(P0,0), pw0[1]=PKW(P0,2), pw0); \
    VRD(4); SBAR(); GAPA(C1=__builtin_amdgcn_mfma_f32_32x32x16_bf16(kf[1],qr[0],negm,0,0,0), P0[6],P0[7],P0[8],P0[9],     pw0[2]=PKW(P0,4), pw0[3]=PKW(P0,6), pw0); \
    VRD(1); SBAR(); GAPA(C0=__builtin_amdgcn_mfma_f32_32x32x16_bf16(kf[2],qr[1],C0,0,0,0),   P0[10],P0[11],P0[12],P0[13], pw1[0]=PKW(P0,8), pw1[1]=PKW(P0,10), pw1); \
    VRD(5); SBAR(); GAPA(C1=__builtin_amdgcn_mfma_f32_32x32x16_bf16(kf[3],qr[1],C1,0,0,0),   P0[14],P0[15],P1[0],P1[1],   pw1[2]=PKW(P0,12),pw1[3]=PKW(P0,14), pw1); \
    VRD(2); SBAR(); GAPA(C0=__builtin_amdgcn_mfma_f32_32x32x16_bf16(kf[4],qr[2],C0,0,0,0),   P1[2],P1[3],P1[4],P1[5],     pw2[0]=PKW(P1,0), pw2[1]=PKW(P1,2), pw2); \
    VRD(6); SBAR(); GAPA(C1=__builtin_amdgcn_mfma_f32_32x32x16_bf16(kf[5],qr[2],C1,0,0,0),   P1[6],P1[7],P1[8],P1[9],     pw2[2]=PKW(P1,4), pw2[3]=PKW(P1,6), pw2); \
    VRD(3); SBAR(); GAPA(C0=__builtin_amdgcn_mfma_f32_32x32x16_bf16(kf[6],qr[3],C0,0,0,0),   P1[10],P1[11],P1[12],P1[13], pw3[0]=PKW(P1,8), pw3[1]=PKW(P1,10), pw3); \
    VRD(7); SBAR(); GAPA(C1=__builtin_amdgcn_mfma_f32_32x32x16_bf16(kf[7],qr[3],C1,0,0,0),   P1[14],P1[15],0.f,0.f,       pw3[2]=PKW(P1,12),pw3[3]=PKW(P1,14), pw3); \
    l_reg+=sacc; \
    if(dma_en){ if(GK){DMA_K((t)+3,sl_cur);} if(GV){DMA_V((t)+1,sl_next);} } \
    CMASK(C0,C1,t); \
    { float a=MX3(C0[0],C0[1],C1[0]),b=MX3(C0[2],C0[3],C1[1]); a=MX3(a,C1[2],C1[3]); \
      _Pragma("unroll") for(int r=4;r<16;r+=4){a=MX3(a,C0[r],C0[r+1]);b=MX3(b,C0[r+2],C0[r+3]);a=MX3(a,C1[r],C1[r+1]);b=MX3(b,C1[r+2],C1[r+3]);} \
      float rm=__builtin_fmaxf(a,b); { auto rr=__builtin_amdgcn_permlane32_swap(__float_as_uint(rm),__float_as_uint(rm),false,false); rm=__builtin_fmaxf(__uint_as_float(rr[0]),__uint_as_float(rr[1])); } \
      resc=false; \
      if(__builtin_expect(__any(rm>(float)THRL),0)){ const float dl=__builtin_fmaxf(rm,0.f); mhat+=dl; \
        _Pragma("unroll") for(int r=0;r<16;++r){C0[r]-=dl;C1[r]-=dl;} \
        _Pragma("unroll") for(int r=0;r<16;++r)negm[r]=-mhat; asm volatile("":"+v"(negm)); \
        const float f=__builtin_amdgcn_exp2f(-dl); l_reg*=f; if(hi==0)wsf[r32]=f; resc=true; } } \
    SBAR(); \
    GAPB(o[0]=__builtin_amdgcn_mfma_f32_32x32x16_bf16(PAF(0),VFR(0),o[0],0,0,0), C0,0); \
    GAPB(o[1]=__builtin_amdgcn_mfma_f32_32x32x16_bf16(PAF(0),VFR(4),o[1],0,0,0), C0,4); \
    KRD(GL,0); GAPB(o[0]=__builtin_amdgcn_mfma_f32_32x32x16_bf16(PAF(1),VFR(1),o[0],0,0,0), C0,8); \
    KRD(GL,1); GAPB(o[1]=__builtin_amdgcn_mfma_f32_32x32x16_bf16(PAF(1),VFR(5),o[1],0,0,0), C0,12); \
    KRD(GL,2); GAPB(o[0]=__builtin_amdgcn_mfma_f32_32x32x16_bf16(PAF(2),VFR(2),o[0],0,0,0), C1,0); \
    KRD(GL,3); GAPB(o[1]=__builtin_amdgcn_mfma_f32_32x32x16_bf16(PAF(2),VFR(6),o[1],0,0,0), C1,4); \
    GAPB(o[0]=__builtin_amdgcn_mfma_f32_32x32x16_bf16(PAF(3),VFR(3),o[0],0,0,0), C1,8); \
    GAPB(o[1]=__builtin_amdgcn_mfma_f32_32x32x16_bf16(PAF(3),VFR(7),o[1],0,0,0), C1,12); \
    }while(0)
  int t=1;
  #undef CMASK
  #define CMASK(P0,P1,t) do{}while(0)
  for(;t+5<NT;t+=2){
    STEP(pB0,pB1,pA0,pA1,t,true,true,true);     WAIT_BAR(2); RESC(); ROT();
    STEP(pA0,pA1,pB0,pB1,t+1,true,true,true);   WAIT_BAR(2); RESC(); ROT();
  }
  #undef CMASK
  #define CMASK(P0,P1,t) do{}while(0)
  #define ENDW(tt) do{ if((tt)+3<NT){WAIT_BAR(2);} else if((tt)+2<NT){WAIT_BAR(1);} else {WAIT_BAR(0);} }while(0)
  for(;t+1<NT;t+=2){
    STEP(pB0,pB1,pA0,pA1,t,(t+3<NT),(t+1<NT),(t+1<NT));       ENDW(t);   RESC(); ROT();
    STEP(pA0,pA1,pB0,pB1,t+1,(t+4<NT),(t+2<NT),(t+2<NT));     ENDW(t+1); RESC(); ROT();
  }
  STEP(pB0,pB1,pA0,pA1,NT-1,false,false,false); RESC();
  { float sacc=pB0[0]+pB0[1]; _Pragma("unroll") for(int r=2;r<16;++r)sacc+=pB0[r]; _Pragma("unroll") for(int r=0;r<16;++r)sacc+=pB1[r]; l_reg+=sacc;
    pw0=(u32x4){PKW(pB0,0),PKW(pB0,2),PKW(pB0,4),PKW(pB0,6)};pw1=(u32x4){PKW(pB0,8),PKW(pB0,10),PKW(pB0,12),PKW(pB0,14)};pw2=(u32x4){PKW(pB1,0),PKW(pB1,2),PKW(pB1,4),PKW(pB1,6)};pw3=(u32x4){PKW(pB1,8),PKW(pB1,10),PKW(pB1,12),PKW(pB1,14)};
    SBAR(); pv(o,vb0+vs_cur,PAF(0),PAF(1),PAF(2),PAF(3)); }
  #undef PKW
  #undef PAF
  #undef VFR
  #undef PIN
  #undef MX3
  #undef GAPA
  #undef GAPB
  #undef EX
  #undef VRD
  #undef KRD
  #undef STEP
  #undef ENDW
  {auto rr=__builtin_amdgcn_permlane32_swap(__float_as_uint(l_reg),__float_as_uint(l_reg),false,false);l_reg=__uint_as_float(rr[0])+__uint_as_float(rr[1]);}
  if(hi==0)wsf[32+r32]=l_reg;asm volatile("s_waitcnt lgkmcnt(0)":::"memory");
  float rli[16];
  bool writer=true;
  if(split){
    float*po=part+wid*2048; float*ps=part+8*2048+wid*64;
    #pragma unroll
    for(int d0=0;d0<2;++d0)
      #pragma unroll
      for(int r=0;r<16;++r)__hip_atomic_store(po+(d0*16+r)*64+lane,o[d0][r],__ATOMIC_RELAXED,__HIP_MEMORY_SCOPE_AGENT);
    if(hi==0){__hip_atomic_store(ps+r32,mhat,__ATOMIC_RELAXED,__HIP_MEMORY_SCOPE_AGENT);__hip_atomic_store(ps+32+r32,l_reg,__ATOMIC_RELAXED,__HIP_MEMORY_SCOPE_AGENT);}
    asm volatile("s_waitcnt vmcnt(0)":::"memory");
    unsigned old_=0u; if(lane==0)old_=__hip_atomic_fetch_add(cnt+wid,1u,__ATOMIC_RELAXED,__HIP_MEMORY_SCOPE_AGENT);
    old_=(unsigned)__builtin_amdgcn_readfirstlane((int)old_);
    writer=(old_!=0u);
    if(writer){
      __builtin_amdgcn_fence(__ATOMIC_ACQUIRE,"agent");
      const float*qo=partner+wid*2048; const float*qs=partner+8*2048+wid*64;
      const float mp=__hip_atomic_load(qs+r32,__ATOMIC_RELAXED,__HIP_MEMORY_SCOPE_AGENT),lp=__hip_atomic_load(qs+32+r32,__ATOMIC_RELAXED,__HIP_MEMORY_SCOPE_AGENT);
      const float Mx=__builtin_fmaxf(mhat,mp),fo=__builtin_amdgcn_exp2f(mhat-Mx),fp=__builtin_amdgcn_exp2f(mp-Mx);
      const float inv=__builtin_amdgcn_rcpf(l_reg*fo+lp*fp);
      if(hi==0){wsf[32+r32]=fo*inv;wsf[r32]=fp*inv;} asm volatile("s_waitcnt lgkmcnt(0)":::"memory");
      #pragma unroll
      for(int r=0;r<16;++r){const float so=wsf[32+crow(r,hi)],sp=wsf[crow(r,hi)];
        #pragma unroll
        for(int d0=0;d0<2;++d0)o[d0][r]=o[d0][r]*so+__hip_atomic_load(qo+(d0*16+r)*64+lane,__ATOMIC_RELAXED,__HIP_MEMORY_SCOPE_AGENT)*sp;
        rli[r]=1.f;}
    }
  } else {
  #pragma unroll
  for(int r=0;r<16;++r)rli[r]=__builtin_amdgcn_rcpf(wsf[32+crow(r,hi)]);
  }
  bf16*Ow=O0+(long)(wid*QBLK)*OP;
  if(writer){ bf16*stg=(bf16*)(shm+LDS_OST)+wid*2048;
    #pragma unroll
    for(int r=0;r<16;++r){const int orow=crow(r,hi);
      #pragma unroll
      for(int d0=0;d0<2;++d0)stg[orow*64+d0*32+r32]=__float2bfloat16(o[d0][r]*rli[r]);}
    asm volatile("s_waitcnt lgkmcnt(0)":::"memory");
    #pragma unroll
    for(int i=0;i<4;++i){const int row=i*8+(lane>>3),ch=lane&7; const u32x4 v=*(const u32x4*)(stg+row*64+ch*8); ATTN_STORE16(Ow+(long)row*OP+ch*8,v);} }
  asm volatile("s_waitcnt lgkmcnt(0)\n\ts_barrier":::"memory");
  #undef DMA_K
  #undef DMA_V
  #undef CMASK
  #undef START
  #undef RESC
  #undef ROT
}
constexpr int ATTN_LDS_BYTES=LDS_BYTES;
#undef SBAR
#undef WAIT_BAR
}
#define GAS __attribute__((address_space(1)))
#define LAS __attribute__((address_space(3)))
typedef unsigned short bf16;
typedef unsigned v4u __attribute__((ext_vector_type(4)));
typedef unsigned v2u __attribute__((ext_vector_type(2)));
typedef float f32x4 __attribute__((ext_vector_type(4)));
#define LDS_WAIT() asm volatile("s_waitcnt lgkmcnt(0)" ::: "memory")
__device__ __forceinline__ unsigned f2bf(float f) { unsigned u = __builtin_bit_cast(unsigned, f); return (u + 0x7fffu + ((u >> 16) & 1u)) >> 16; }
__device__ __forceinline__ unsigned pk2(float lo, float hi) { return pg8::cvt_pk_bf16(lo, hi); }
__device__ __forceinline__ float bf_lo(unsigned w) { return __builtin_bit_cast(float, w << 16); }
__device__ __forceinline__ float bf_hi(unsigned w) { return __builtin_bit_cast(float, w & 0xffff0000u); }
typedef _Float16 h16x2 __attribute__((ext_vector_type(2)));
__device__ __forceinline__ unsigned pkh2(float lo, float hi) { h16x2 v = {(_Float16)lo, (_Float16)hi}; return __builtin_bit_cast(unsigned, v); }
__device__ __forceinline__ float h_lo(unsigned w) { return (float)__builtin_bit_cast(h16x2, w).x; }
__device__ __forceinline__ float h_hi(unsigned w) { return (float)__builtin_bit_cast(h16x2, w).y; }

constexpr int D = 1024, NCTX = 8192, NLAT = 4096, M = NCTX + NLAT, DEPTH = 4, SEQ = 256, LSEQ = 2048, PAST = 512, LKEYS = PAST + LSEQ;
constexpr int NIN = 1280, DFF = 2816, NUP = 2 * DFF, NMOD = 6 * D;
constexpr float EPS = 1e-6f;
constexpr int NWAVES = 8, NTHR = 512;
constexpr size_t MiB = 1u << 20;
constexpr size_t WS_ZERO_BYTES = 2 * MiB;
constexpr size_t WS_MOD = 1 * MiB;
constexpr size_t WS_ACNT = 64 * 1024;
constexpr int APART_FLOATS = 8 * 2048 + 8 * 64;
constexpr size_t WS_APART = 222 * MiB;
constexpr size_t WS_RS = 262 * MiB;
constexpr size_t WS_GM = 12 * MiB + 512 * 1024;
constexpr size_t WS_B1 = 12 * MiB + 768 * 1024;
constexpr size_t WS_B5 = 13 * MiB;
constexpr size_t WS_WIN = 2 * MiB;
constexpr size_t WS_WOUT = 14 * MiB;
constexpr size_t WS_WUP = 22 * MiB;
constexpr size_t WS_WDN = 66 * MiB;
constexpr size_t WS_X = 88 * MiB;
constexpr size_t WS_H = 354 * MiB;
constexpr size_t WS_Q = 160 * MiB;
constexpr size_t WS_U = 172 * MiB;
constexpr size_t WS_AO = 184 * MiB;
constexpr size_t WS_ACT = 136 * MiB;
constexpr size_t WS_KC = 208 * MiB, WS_VC = 210 * MiB;
constexpr size_t WS_KL = 212 * MiB, WS_VL = 217 * MiB;
constexpr size_t WS_HALO = 222 * MiB + 32 * MiB;
constexpr size_t WS_Z = 222 * MiB;
constexpr size_t WS_END = 378 * MiB;
static_assert(WS_ACT + (size_t)M * DFF * 2 <= WS_KC, "ACT overlay");
constexpr int LDS_BYTES = 147456;

struct Args { const float* in[21]; float* out; unsigned char* ws; int ph_lo, ph_hi; };
enum { I_XP = 0, I_XS, I_CK, I_CV, I_C, I_CCTX, I_WMOD, I_BMOD, I_N1G, I_WIN, I_QG, I_KG, I_WPOOL, I_PSC, I_WOUT, I_N2G, I_WUP, I_CW, I_CB, I_WDN, I_FNG };

__device__ __forceinline__ float xadd16(float v) { auto r = __builtin_amdgcn_permlane16_swap(__float_as_uint(v), __float_as_uint(v), false, false); return __uint_as_float(r[0]) + __uint_as_float(r[1]); }
__device__ __forceinline__ float xadd32(float v) { auto r = __builtin_amdgcn_permlane32_swap(__float_as_uint(v), __float_as_uint(v), false, false); return __uint_as_float(r[0]) + __uint_as_float(r[1]); }
template <int CTRL> __device__ __forceinline__ float dpp_f(float v) { return __int_as_float(__builtin_amdgcn_update_dpp(0, __float_as_int(v), CTRL, 0xf, 0xf, false)); }
__device__ __forceinline__ float wave_sum(float v) {
    v += dpp_f<0xB1>(v);
    v += dpp_f<0x4E>(v);
    v += dpp_f<0x124>(v);
    v += dpp_f<0x128>(v);
    return xadd32(xadd16(v));
}
__device__ __forceinline__ const float* ain(const Args& a, int i) { asm volatile("" : "+s"(i)); return a.in[i]; }
__device__ __forceinline__ int row_cond(int row) { return row < NCTX ? 0 : 1 + ((row - NCTX) >> 11); }

struct TrItem { const float* src; bf16* dst; int ldw, ldt; };
__device__ __forceinline__ void tr_load(const TrItem& t, float (&r)[32], int lane) {
#pragma unroll
    for (int i = 0; i < 32; ++i) r[i] = t.src[(size_t)(2 * i + (lane >> 5)) * t.ldw + (lane & 31)];
}
__device__ __forceinline__ void tr_store(const TrItem& t, const float (&r)[32], LAS float* scr, int lane) {
#pragma unroll
    for (int i = 0; i < 32; ++i) scr[(2 * i + (lane >> 5)) * 33 + (lane & 31)] = r[i];
    LDS_WAIT(); asm volatile("" ::: "memory");
    const int c = lane & 7;
#pragma unroll
    for (int j = 0; j < 4; ++j) { const int n = (lane >> 3) + 8 * j; const LAS float* s = scr + (8 * c) * 33 + n;
        v4u o; o.x = pk2(s[0 * 33], s[1 * 33]); o.y = pk2(s[2 * 33], s[3 * 33]); o.z = pk2(s[4 * 33], s[5 * 33]); o.w = pk2(s[6 * 33], s[7 * 33]);
        *(v4u*)(t.dst + (size_t)n * t.ldt + 8 * c) = o; }
    LDS_WAIT(); asm volatile("" ::: "memory");
}
__device__ __forceinline__ float silu_f(float x) { return x / (1.f + __expf(-x)); }

__device__ __forceinline__ void weff_layer(const Args& a, unsigned char* ws, LAS unsigned char* lds, int gw, int NGW, int lane, int wave, int l) {
    {
        LAS float* wps = (LAS float*)(lds + wave * 12288);
        for (int it = gw; it < 4 * 8 * 16; it += NGW) {
            const int nb = it & 15, ib = (it >> 4) & 7, g = (it >> 7) & 3;
            const float* wp = ain(a, I_WPOOL) + ((size_t)(l * 4 + g) * 128 + ib * 16) * 128;
            const float* ps = ain(a, I_PSC) + l * 512 + g * 128;
            const float* wo = ain(a, I_WOUT) + ((size_t)l * D + 512 + g * 128) * D + nb * 64 + lane;
            { const int ii = lane >> 2, js = (lane & 3) * 32;
#pragma unroll
                for (int q = 0; q < 8; ++q) { const f32x4 w = *(const f32x4*)(wp + ii * 128 + js + 4 * q) * *(const f32x4*)(ps + js + 4 * q);
                    wps[(js + 4 * q + 0) * 16 + ii] = w.x; wps[(js + 4 * q + 1) * 16 + ii] = w.y; wps[(js + 4 * q + 2) * 16 + ii] = w.z; wps[(js + 4 * q + 3) * 16 + ii] = w.w; } }
            LDS_WAIT(); asm volatile("" ::: "memory");
            f32x4 acc[4];
#pragma unroll
            for (int i = 0; i < 4; ++i) acc[i] = (f32x4){0.f, 0.f, 0.f, 0.f};
#pragma unroll 32
            for (int j = 0; j < 128; ++j) { const float wv = wo[(size_t)j * D];
#pragma unroll
                for (int i = 0; i < 4; ++i) acc[i] += *(const LAS f32x4*)(wps + j * 16 + 4 * i) * wv; }
            bf16* dst = (bf16*)(ws + WS_WOUT) + ((size_t)l * D + nb * 64 + lane) * D + 512 + g * 128 + ib * 16;
            v4u o0, o1; o0.x = pk2(acc[0].x, acc[0].y); o0.y = pk2(acc[0].z, acc[0].w); o0.z = pk2(acc[1].x, acc[1].y); o0.w = pk2(acc[1].z, acc[1].w);
            o1.x = pk2(acc[2].x, acc[2].y); o1.y = pk2(acc[2].z, acc[2].w); o1.z = pk2(acc[3].x, acc[3].y); o1.w = pk2(acc[3].z, acc[3].w);
            *(v4u*)dst = o0; *(v4u*)(dst + 8) = o1;
            LDS_WAIT(); asm volatile("" ::: "memory");
        }
    }
}
__device__ __forceinline__ void convert_layer(const Args& a, unsigned char* ws, LAS unsigned char* lds, int gw, int NGW, int lane, int wave, int l, int part) {
    {
        LAS float* scr = (LAS float*)(lds + wave * 12288);
        constexpr int I_IN = 16 * 40, I_OUT = 8 * 32, I_UP = 16 * 176, I_DN = 44 * 32, I_L = I_IN + I_OUT + I_UP + I_DN;
        auto decode = [&](int it) -> TrItem {
            int r = it; TrItem t;
            if (r < I_IN) { const int kb = r / 40, nb = r % 40, n0 = nb * 32, pn = n0 >> 8, lc = n0 & 255, wc = lc >> 6, bj = (lc >> 5) & 1;
                t.src = ain(a, I_WIN) + (size_t)l * D * NIN + (size_t)(kb * 64) * NIN + n0; t.ldw = NIN;
                t.dst = (bf16*)(ws + WS_WIN) + (size_t)l * NIN * D + (size_t)(pn * 256 + bj * 128 + wc * 32) * D + kb * 64; t.ldt = D; return t; }
            r -= I_IN;
            if (r < I_OUT) { const int kb = r / 32, nb = r % 32;
                t.src = ain(a, I_WOUT) + (size_t)l * D * D + (size_t)(kb * 64) * D + nb * 32; t.ldw = D;
                t.dst = (bf16*)(ws + WS_WOUT) + (size_t)l * D * D + (size_t)(nb * 32) * D + kb * 64; t.ldt = D; return t; }
            r -= I_OUT;
            if (r < I_UP) { const int kb = r / 176, nb = r % 176, n0 = nb * 32, hf = n0 >= DFF, chn = n0 - hf * DFF;
                t.src = ain(a, I_WUP) + (size_t)l * D * NUP + (size_t)(kb * 64) * NUP + n0; t.ldw = NUP;
                t.dst = (bf16*)(ws + WS_WUP) + (size_t)l * NUP * D + (size_t)((chn >> 7) * 256 + hf * 128 + (chn & 127)) * D + kb * 64; t.ldt = D; return t; }
            r -= I_UP;
            { const int kb = r / 32, nb = r % 32;
                t.src = ain(a, I_WDN) + (size_t)l * DFF * D + (size_t)(kb * 64) * D + nb * 32; t.ldw = D;
                t.dst = (bf16*)(ws + WS_WDN) + (size_t)l * D * DFF + (size_t)(nb * 32) * DFF + kb * 64; t.ldt = DFF; return t; }
        };
        const int it0 = (part == 1 ? I_IN + I_OUT : 0) + gw, NIT = (part == 0 ? I_IN + I_OUT : I_L);
        if (it0 < NIT) {
            TrItem cur = decode(it0); float rc[32]; tr_load(cur, rc, lane);
            for (int it = it0; it < NIT; it += NGW) {
                const bool has = it + NGW < NIT; TrItem nxt = cur; float rn[32];
                if (has) { nxt = decode(it + NGW); tr_load(nxt, rn, lane); }
                tr_store(cur, rc, scr, lane);
                if (has) { cur = nxt;
#pragma unroll
                    for (int i = 0; i < 32; ++i) rc[i] = rn[i]; }
            }
        }
    }
}
__device__ __forceinline__ void prologue(const Args& a, LAS unsigned char* lds, int vcu, int G, int tid, int lane, int wave, int nl_pre) {
    size_t wz_ = 0; asm volatile("" : "+s"(wz_)); unsigned char* ws = a.ws + wz_;
    const int gw = vcu * NWAVES + wave, NGW = G * NWAVES;
    {
        typedef float f32x2_ __attribute__((ext_vector_type(2)));
        LAS f32x2_* red = (LAS f32x2_*)lds;
        const float* cc = ain(a, I_CCTX); const float* c1 = ain(a, I_C);
        for (int it = vcu; it < DEPTH * 48; it += G) {
            const int l = it / 48, cb = it % 48;
            const float* W = ain(a, I_WMOD) + (size_t)l * D * NMOD + cb * 128 + lane * 2;
            f32x2_ a0 = {0.f, 0.f}, a1 = a0, a2 = a0;
            const int kb = wave * 128;
#pragma unroll 32
            for (int k = 0; k < 128; ++k) {
                const f32x2_ w = *(const f32x2_*)(W + (size_t)(kb + k) * NMOD);
                const float s0 = silu_f(cc[kb + k]), s1 = silu_f(c1[kb + k]), s2 = silu_f(c1[D + kb + k]);
                a0 += w * s0; a1 += w * s1; a2 += w * s2;
            }
            red[(wave * 3 + 0) * 64 + lane] = a0; red[(wave * 3 + 1) * 64 + lane] = a1; red[(wave * 3 + 2) * 64 + lane] = a2;
            __syncthreads();
            if (tid < 192) { const int cnd = tid >> 6; f32x2_ s = *(const f32x2_*)(ain(a, I_BMOD) + (size_t)l * NMOD + cb * 128 + lane * 2);
#pragma unroll
                for (int w = 0; w < 8; ++w) s += red[(w * 3 + cnd) * 64 + lane];
                *(f32x2_*)((float*)(ws + WS_MOD) + ((size_t)l * 3 + cnd) * NMOD + cb * 128 + lane * 2) = s; }
            __syncthreads();
        }
    }
#ifdef PROBE_PRO2
    for (int rep_ = 0; rep_ < 2; ++rep_) {
#endif
    for (int it = gw * 64 + lane; it < 2 * DEPTH * PAST * 16 * 2; it += NGW * 64) {
        const int which = it & 1, r = it >> 1, c8 = r & 15, p = (r >> 4) & 511, l = (r >> 13) & 3, b = r >> 15;
        const float* src = a.in[which ? I_CV : I_CK] + (((size_t)(b * DEPTH + l) * PAST + p) * 128 + c8 * 8);
        const f32x4 x0 = *(const f32x4*)src, x1 = *(const f32x4*)(src + 4);
        v4u o; o.x = pk2(x0.x, x0.y); o.y = pk2(x0.z, x0.w); o.z = pk2(x1.x, x1.y); o.w = pk2(x1.z, x1.w);
        *(v4u*)((bf16*)(ws + (which ? WS_VL : WS_KL)) + (((size_t)(l * 2 + b) * LKEYS + p) * 128 + c8 * 8)) = o;
    }
    for (int l = 0; l < nl_pre; ++l) { weff_layer(a, ws, lds, gw, NGW, lane, wave, l); convert_layer(a, ws, lds, gw, NGW, lane, wave, l, 2); }
#ifdef PROBE_PRO2
    }
#endif
}

__device__ __forceinline__ void bias_rows(unsigned char* ws, int gw, int NGW, int lane, int l, bool up) {
    const float* mod = (const float*)(ws + WS_MOD);
    for (int n = gw; n < (up ? NUP : NIN); n += NGW) {
        const bf16* wrow = up ? (const bf16*)(ws + WS_WUP) + ((size_t)l * NUP + n) * D : (const bf16*)(ws + WS_WIN) + ((size_t)l * NIN + n) * D;
        const v4u w0 = *(const v4u*)(wrow + lane * 16), w1 = *(const v4u*)(wrow + lane * 16 + 8);
        float wf[16] = {bf_lo(w0.x), bf_hi(w0.x), bf_lo(w0.y), bf_hi(w0.y), bf_lo(w0.z), bf_hi(w0.z), bf_lo(w0.w), bf_hi(w0.w),
                        bf_lo(w1.x), bf_hi(w1.x), bf_lo(w1.y), bf_hi(w1.y), bf_lo(w1.z), bf_hi(w1.z), bf_lo(w1.w), bf_hi(w1.w)};
        float s[3];
#pragma unroll
        for (int c = 0; c < 3; ++c) { const float* sh = mod + ((size_t)l * 3 + c) * NMOD + (up ? 3 * D : 0) + lane * 16; float acc = 0.f;
#pragma unroll
            for (int q = 0; q < 4; ++q) { const f32x4 x = *(const f32x4*)(sh + 4 * q); acc += (x.x * wf[4 * q] + x.y * wf[4 * q + 1]) + (x.z * wf[4 * q + 2] + x.w * wf[4 * q + 3]); }
            s[c] = wave_sum(acc); }
        if (lane == 0) { float* o = up ? (float*)(ws + WS_B5) + (size_t)l * 3 * NUP + n : (float*)(ws + WS_B1) + (size_t)l * 3 * NIN + n; const int st = up ? NUP : NIN;
            o[0] = s[0]; o[st] = s[1]; o[2 * st] = s[2]; }
    }
}
__device__ __forceinline__ void phase1(const Args& a, int gw, int NGW, int lane, int nl_pre) {
    size_t wz_ = 0; asm volatile("" : "+s"(wz_)); unsigned char* ws = a.ws + wz_;
    const float* mod = (const float*)(ws + WS_MOD);
    for (int it = gw * 64 + lane; it < DEPTH * 2 * 3 * D; it += NGW * 64) {
        const int col = it & 1023, cnd = (it >> 10) % 3, w = ((it >> 10) / 3) & 1, l = (it >> 10) / 6;
        const float g = (w ? ain(a, I_N2G) : ain(a, I_N1G))[l * D + col];
        ((float*)(ws + WS_GM))[it] = g * (1.f + mod[((size_t)l * 3 + cnd) * NMOD + (w ? 4 * D : D) + col]);
    }
    for (int l = 0; l < nl_pre; ++l) { bias_rows(ws, gw, NGW, lane, l, false); bias_rows(ws, gw, NGW, lane, l, true); }
    bf16* X = (bf16*)(ws + WS_X);
    f32x4 g[4];
#pragma unroll
    for (int j = 0; j < 4; ++j) g[j] = *(const f32x4*)(ain(a, I_N1G) + 256 * j + lane * 4);
    for (int row = gw; row < M; row += NGW) {
        const float* src = row < NCTX ? ain(a, I_XP) + (size_t)row * D : ain(a, I_XS) + (size_t)(row - NCTX) * D;
        const float* sc = mod + (size_t)row_cond(row) * NMOD + D;
        bf16* h = (bf16*)(ws + WS_H) + (size_t)row * D;
        float s = 0.f;
#pragma unroll
        for (int j = 0; j < 4; ++j) { const f32x4 v = *(const f32x4*)(src + 256 * j + lane * 4); s += (v.x * v.x + v.y * v.y) + (v.z * v.z + v.w * v.w);
            const f32x4 y = v * g[j] * (*(const f32x4*)(sc + 256 * j + lane * 4) + 1.f);
            v2u o; o.x = pk2(y.x, y.y); o.y = pk2(y.z, y.w); *(v2u*)(h + 256 * j + lane * 4) = o;
            v2u xo_; xo_.x = pkh2(v.x, v.y); xo_.y = pkh2(v.z, v.w); *(v2u*)(X + (size_t)row * D + 256 * j + lane * 4) = xo_; }
        s = wave_sum(s);
        if (lane == 0) *(f32x4*)((float*)(ws + WS_RS) + (size_t)row * 4) = (f32x4){s, 0.f, 0.f, 0.f};
    }
}
__device__ __forceinline__ void final_norm(const Args& a, int gw, int NGW, int lane) {
    size_t wz_ = 0; asm volatile("" : "+s"(wz_)); unsigned char* ws = a.ws + wz_;     const bf16* X = (const bf16*)(ws + WS_X);
    f32x4 g[4];
#pragma unroll
    for (int j = 0; j < 4; ++j) g[j] = *(const f32x4*)(ain(a, I_FNG) + 256 * j + lane * 4);
    for (int row = gw; row < M; row += 2 * NGW) {
        const int row2 = row + NGW; const bool has2 = row2 < M;
        f32x4 v[4], w[4]; float s = 0.f, s2 = 0.f;
#pragma unroll
        for (int j = 0; j < 4; ++j) { const v2u a_ = *(const v2u*)(X + (size_t)row * D + 256 * j + lane * 4); v2u b_ = {0u, 0u}; if (has2) b_ = *(const v2u*)(X + (size_t)row2 * D + 256 * j + lane * 4);
            v[j] = (f32x4){h_lo(a_.x), h_hi(a_.x), h_lo(a_.y), h_hi(a_.y)}; w[j] = (f32x4){h_lo(b_.x), h_hi(b_.x), h_lo(b_.y), h_hi(b_.y)}; }
#pragma unroll
        for (int j = 0; j < 4; ++j) { s += (v[j].x * v[j].x + v[j].y * v[j].y) + (v[j].z * v[j].z + v[j].w * v[j].w); s2 += (w[j].x * w[j].x + w[j].y * w[j].y) + (w[j].z * w[j].z + w[j].w * w[j].w); }
        const float rstd = 1.f / sqrtf(wave_sum(s) * (1.f / D) + EPS), rstd2 = 1.f / sqrtf(wave_sum(s2) * (1.f / D) + EPS);
#pragma unroll
        for (int j = 0; j < 4; ++j) { *(f32x4*)(a.out + (size_t)row * D + 256 * j + lane * 4) = v[j] * rstd * g[j]; if (has2) *(f32x4*)(a.out + (size_t)row2 * D + 256 * j + lane * 4) = w[j] * rstd2 * g[j]; }
    }
}

#ifndef QKV_NOROPE
#define QKV_NOROPE
#endif
namespace pg8 {
__device__ __forceinline__ void rope2(float& x1, float& x2, float rev) { rev = rev - floorf(rev); const float sn = __builtin_amdgcn_sinf(rev), cs = __builtin_amdgcn_cosf(rev); const float a = x1 * cs - x2 * sn, b = x1 * sn + x2 * cs; x1 = a; x2 = b; }
template <int KIND> __device__ __forceinline__ void qkv_rows(const f32x4 (&acc)[2][2][4][2], bf16_t* dst0, int pitch, float* c0, const float* gp, bool lat, int t0, int fq, const float* rs0, const float* bp) {
    float rstd_in[2][4];
#pragma unroll
    for (int ai = 0; ai < 2; ++ai) {
#pragma unroll
        for (int m = 0; m < 4; ++m) { const f32x4 p_ = *(const f32x4*)(rs0 + (ai * HALF + m * 16) * 4); rstd_in[ai][m] = __builtin_amdgcn_rsqf(((p_.x + p_.y) + (p_.z + p_.w)) * (1.f / 1024.f) + 1e-6f); }
        asm volatile("" : "+v"(rstd_in[ai][0]), "+v"(rstd_in[ai][1]), "+v"(rstd_in[ai][2]), "+v"(rstd_in[ai][3]) :: "memory");
    }
    const f32x4 b00 = *(const f32x4*)(bp), b01 = *(const f32x4*)(bp + 16), b10 = *(const f32x4*)(bp + 128), b11 = *(const f32x4*)(bp + 144);
    f32x4 g00 = {1.f, 1.f, 1.f, 1.f}, g01 = g00, g10 = g00, g11 = g00;
    if (KIND < 2) { g00 = *(const f32x4*)(gp); g01 = *(const f32x4*)(gp + 16); g10 = *(const f32x4*)(gp + 32); g11 = *(const f32x4*)(gp + 48); }
    float i0 = 0.f, i1 = 0.f, i2 = 0.f, i3 = 0.f;
    if (KIND < 2) { const float k = -(13.287712379549449f / 16.0f), r2pi = 0.15915494309189535f;
        i0 = __builtin_amdgcn_exp2f((float)(4 * fq + 0) * k) * r2pi; i1 = __builtin_amdgcn_exp2f((float)(4 * fq + 1) * k) * r2pi;
        i2 = __builtin_amdgcn_exp2f((float)(4 * fq + 2) * k) * r2pi; i3 = __builtin_amdgcn_exp2f((float)(4 * fq + 3) * k) * r2pi; }
    const float qscale = KIND == 0 ? 0.125f * 1.4426950408889634f : 1.f;
#pragma unroll
    for (int ai = 0; ai < 2; ++ai)
#pragma unroll
        for (int m = 0; m < 4; ++m) {
            const int dr = ai * HALF + m * 16;
            bf16_t* dst = dst0; float* co = c0; asm volatile("" : "+v"(dst), "+v"(co));
            GAS bf16_t* dstg = (GAS bf16_t*)dst + dr * pitch; GAS float* cog = (GAS float*)co + dr * 128;
            const float ri = rstd_in[ai][m];
            f32x4 v00 = acc[ai][0][m][0] * ri + b00, v01 = acc[ai][0][m][1] * ri + b01, v10 = acc[ai][1][m][0] * ri + b10, v11 = acc[ai][1][m][1] * ri + b11;
            if (KIND < 2) {
                float ss = ((v00.x * v00.x + v00.y * v00.y) + (v00.z * v00.z + v00.w * v00.w)) + ((v01.x * v01.x + v01.y * v01.y) + (v01.z * v01.z + v01.w * v01.w))
                         + ((v10.x * v10.x + v10.y * v10.y) + (v10.z * v10.z + v10.w * v10.w)) + ((v11.x * v11.x + v11.y * v11.y) + (v11.z * v11.z + v11.w * v11.w));
                ss = ::xadd32(::xadd16(ss));
                const float rstd = __builtin_amdgcn_rsqf(ss * (1.f / 64.f) + 1e-6f);
                v00 = v00 * rstd * g00; v01 = v01 * rstd * g01; v10 = v10 * rstd * g10; v11 = v11 * rstd * g11;
                if (lat) {
                    const int t = t0 + dr; const float pr = (float)(t >> 6), pc = (float)(t & 63);
#define ROPE2(A, B, C, REV) do { float x1_ = A.C, x2_ = B.C; rope2(x1_, x2_, REV); A.C = x1_; B.C = x2_; } while (0)
                    ROPE2(v00, v01, x, pr * i0); ROPE2(v00, v01, y, pr * i1); ROPE2(v00, v01, z, pr * i2); ROPE2(v00, v01, w, pr * i3);
                    ROPE2(v10, v11, x, pc * i0); ROPE2(v10, v11, y, pc * i1); ROPE2(v10, v11, z, pc * i2); ROPE2(v10, v11, w, pc * i3);
#undef ROPE2
                }
            }
            if ((KIND == 1 || KIND == 2) && !lat) { *(GAS f32x4*)(cog) = v00; *(GAS f32x4*)(cog + 16) = v01; *(GAS f32x4*)(cog + 32) = v10; *(GAS f32x4*)(cog + 48) = v11; }
            typedef unsigned u32x2 __attribute__((ext_vector_type(2)));
            v00 = v00 * qscale; v01 = v01 * qscale; v10 = v10 * qscale; v11 = v11 * qscale;
            u32x2 w;
            w.x = cvt_pk_bf16(v00.x, v00.y); w.y = cvt_pk_bf16(v00.z, v00.w); *(GAS u32x2*)(dstg) = w;
            w.x = cvt_pk_bf16(v01.x, v01.y); w.y = cvt_pk_bf16(v01.z, v01.w); *(GAS u32x2*)(dstg + 16) = w;
            w.x = cvt_pk_bf16(v10.x, v10.y); w.y = cvt_pk_bf16(v10.z, v10.w); *(GAS u32x2*)(dstg + 32) = w;
            w.x = cvt_pk_bf16(v11.x, v11.y); w.y = cvt_pk_bf16(v11.z, v11.w); *(GAS u32x2*)(dstg + 48) = w;
            if (m & 1) __builtin_amdgcn_sched_barrier(0);
        }
}
struct EpiQKV {
    static constexpr bool PERM = false, AFTER_DRAIN = false;
    unsigned char* ws; float* out; const float *qg, *kg; int layer;
    __device__ __forceinline__ void operator()(const f32x4 (&acc)[2][2][4][2], const Unit& u, int wr, int wc, int fr, int fq) const {
        { int t_ = threadIdx.x; asm volatile("" : "+v"(t_)); fr = t_ & 15; fq = (t_ >> 4) & 3; }
        const int pn = u.pn; const bool lat = u.pm >= 32;
        const int cnd = u.pm < 32 ? 0 : 1 + ((u.pm - 32) >> 3);
        const float* rs0 = (const float*)(ws + WS_RS) + ((size_t)(2 * layer) * 12288 + (u.pm * BM + wr * 64 + fr)) * 4;
        const float* bp = (const float*)(ws + WS_B1) + ((size_t)layer * 3 + cnd) * 1280 + pn * BM + wc * 32 + 4 * fq;
        const int row0 = u.pm * BM + wr * 64 + fr;
        int t0 = (row0 - 8192) & 2047;
        asm volatile("" : "+v"(t0));
        if (pn < 2) {
            qkv_rows<0>(acc, (bf16_t*)(ws + WS_Q) + (size_t)row0 * 512 + (4 * pn + wc) * 64 + 4 * fq, 512, nullptr, qg + 4 * fq, lat, t0, fq, rs0, bp);
        } else if (pn == 2) {
            const int hh = wc & 1; const bool isk = wc < 2;
            size_t doff;
            if (!lat) doff = (isk ? WS_KC : WS_VC) + ((size_t)row0 * 128 + hh * 64) * 2;
            else { const int b = (row0 - 8192) >> 11; doff = (isk ? WS_KL : WS_VL) + (((size_t)(layer * 2 + b) * 2560 + 512 + ((row0 - 8192) & 2047)) * 128 + hh * 64) * 2; }
            bf16_t* dst0 = (bf16_t*)(ws + doff) + 4 * fq;
            float* c0 = out + (size_t)12288 * 1024 + (isk ? 0 : (size_t)32 * 4 * 256 * 128) + ((size_t)((row0 >> 8) * 4 + layer) * 256 + (row0 & 255)) * 128 + hh * 64 + 4 * fq;
            if (isk) qkv_rows<1>(acc, dst0, 128, c0, kg + 4 * fq, lat, t0, fq, rs0, bp); else qkv_rows<2>(acc, dst0, 128, c0, kg, lat, t0, fq, rs0, bp);
        } else {
            qkv_rows<3>(acc, (bf16_t*)(ws + WS_U) + (size_t)row0 * 512 + (pn - 3) * 256 + wc * 64 + 4 * fq, 512, nullptr, kg, lat, t0, fq, rs0, bp);
        }
    }
};
struct EpiRes {
    static constexpr bool PERM = true, AFTER_DRAIN = false;
    unsigned char* ws; const float* gate;
    int ninst;
    PG8_LAS float* XB;
    __device__ __forceinline__ void operator()(const f32x4 (&acc)[2][2][4][2], const Unit& u, int wr, int wc, int fr, int fq) const {
#ifdef PROBE_DUP
        if (ninst == -2) return;
#endif
        int tl; { int t_ = threadIdx.x; asm volatile("" : "+v"(t_)); fr = t_ & 15; fq = (t_ >> 4) & 3; tl = t_; }
        const int cnd = u.pm < 32 ? 0 : 1 + ((u.pm - 32) >> 3);
        const int col0 = u.pn * BM + wc * 32 + 8 * fq; const float* gp = gate + (size_t)cnd * 6144 + col0;
        const float* gm = (const float*)(ws + WS_GM) + ((size_t)(ninst < 0 ? 0 : ninst) * 3 + cnd) * 1024 + col0;
        const int row0 = u.pm * BM + wr * 64 + fr;
        bf16_t* x0 = (bf16_t*)(ws + WS_X) + (size_t)row0 * 1024 + col0;
        bf16_t* h0 = (bf16_t*)(ws + WS_H) + (size_t)row0 * 1024 + col0;
        f32x4 gt[2][2], gn[2][2];
#pragma unroll
        for (int bj = 0; bj < 2; ++bj)
#pragma unroll
            for (int n = 0; n < 2; ++n) { gt[bj][n] = *(const f32x4*)(gp + bj * HALF + 4 * n); gn[bj][n] = *(const f32x4*)(gm + bj * HALF + 4 * n); }
#pragma unroll
        for (int ai = 0; ai < 2; ++ai)
#pragma unroll
            for (int m = 0; m < 4; ++m) { const int dr = ai * HALF + m * 16;
                bf16_t* xr_ = x0; bf16_t* hr_ = h0; asm volatile("" : "+v"(xr_), "+v"(hr_)); GAS bf16_t* xr = (GAS bf16_t*)xr_ + dr * 1024; GAS bf16_t* hr = (GAS bf16_t*)hr_ + dr * 1024;
                float ss = 0.f;
#pragma unroll
                for (int bj = 0; bj < 2; ++bj) {
                    const u32x4 xo = *(const GAS u32x4*)(xr + bj * HALF);
                    const f32x4 o0 = {::h_lo(xo.x), ::h_hi(xo.x), ::h_lo(xo.y), ::h_hi(xo.y)}, o1 = {::h_lo(xo.z), ::h_hi(xo.z), ::h_lo(xo.w), ::h_hi(xo.w)};
                    const f32x4 x0v = o0 + gt[bj][0] * acc[ai][bj][m][0], x1v = o1 + gt[bj][1] * acc[ai][bj][m][1];
                    u32x4 xw; xw.x = ::pkh2(x0v[0], x0v[1]); xw.y = ::pkh2(x0v[2], x0v[3]); xw.z = ::pkh2(x1v[0], x1v[1]); xw.w = ::pkh2(x1v[2], x1v[3]);
                    *(GAS u32x4*)(xr + bj * HALF) = xw;
                    if (ninst >= 0) { ss += ((x0v.x * x0v.x + x0v.y * x0v.y) + (x0v.z * x0v.z + x0v.w * x0v.w)) + ((x1v.x * x1v.x + x1v.y * x1v.y) + (x1v.z * x1v.z + x1v.w * x1v.w));
                        const f32x4 y0 = x0v * gn[bj][0], y1 = x1v * gn[bj][1];
                        u32x4 hw; hw.x = cvt_pk_bf16(y0[0], y0[1]); hw.y = cvt_pk_bf16(y0[2], y0[3]); hw.z = cvt_pk_bf16(y1[0], y1[1]); hw.w = cvt_pk_bf16(y1[2], y1[3]);
                        *(GAS u32x4*)(hr + bj * HALF) = hw; } }
                if (ninst >= 0) { ss = ::xadd32(::xadd16(ss)); if (fq == 0) XB[wc * 256 + wr * 64 + fr + dr] = ss; }
                if (m == 3) asm volatile("" ::: "memory"); }
        if (ninst >= 0) {
            asm volatile("s_waitcnt lgkmcnt(0)" ::: "memory"); __builtin_amdgcn_s_barrier(); asm volatile("" ::: "memory");
            if (tl < 256) { const float s_ = (XB[tl] + XB[256 + tl]) + (XB[512 + tl] + XB[768 + tl]);
                ((float*)(ws + WS_RS))[((size_t)ninst * 12288 + u.pm * BM + tl) * 4 + u.pn] = s_; }
        }
    }
};
struct EpiZ {
    static constexpr bool PERM = true, AFTER_DRAIN = false;
    unsigned char* ws; int layer;
    __device__ __forceinline__ void operator()(const f32x4 (&acc)[2][2][4][2], const Unit& u, int wr, int wc, int fr, int fq) const {
        const int cnd = u.pm < 32 ? 0 : 1 + ((u.pm - 32) >> 3);
        const int row0 = u.pm * BM + wr * 64 + fr, col0 = u.pn * BM + wc * 32 + 8 * fq;
        const float* bias = (const float*)(ws + WS_B5) + ((size_t)layer * 3 + cnd) * 5632 + col0;
        const float* rs0 = (const float*)(ws + WS_RS) + (size_t)(2 * layer + 1) * 12288 + row0;
        bf16_t* z0 = (bf16_t*)(ws + WS_Z) + (size_t)row0 * 5632 + col0;
        f32x4 bv[2][2];
#pragma unroll
        for (int bj = 0; bj < 2; ++bj)
#pragma unroll
            for (int n = 0; n < 2; ++n) bv[bj][n] = *(const f32x4*)(bias + bj * HALF + 4 * n);
#pragma unroll
        for (int ai = 0; ai < 2; ++ai)
#pragma unroll
            for (int m = 0; m < 4; ++m) { const int dr = ai * HALF + m * 16;
                bf16_t* zr_ = z0; const float* rsp = rs0; asm volatile("" : "+v"(zr_), "+v"(rsp)); GAS bf16_t* zr = (GAS bf16_t*)zr_ + (size_t)dr * 5632;
                const float rstd = 1.f / sqrtf(((const GAS float*)rsp)[dr] * (1.f / 1024.f) + 1e-6f);
#pragma unroll
                for (int bj = 0; bj < 2; ++bj) { const f32x4 v0 = acc[ai][bj][m][0] * rstd + bv[bj][0], v1 = acc[ai][bj][m][1] * rstd + bv[bj][1];
                    u32x4 w; w.x = cvt_pk_bf16(v0[0], v0[1]); w.y = cvt_pk_bf16(v0[2], v0[3]); w.z = cvt_pk_bf16(v1[0], v1[1]); w.w = cvt_pk_bf16(v1[2], v1[3]);
                    *(GAS u32x4*)(zr + bj * HALF) = w; } }
    }
};
template <int CTRL> __device__ __forceinline__ f32x4 dpp4(const f32x4 v) { f32x4 r;
#pragma unroll
    for (int c = 0; c < 4; ++c) r[c] = __int_as_float(__builtin_amdgcn_update_dpp(0, __float_as_int(v[c]), CTRL, 0xf, 0xf, false)); return r; }
struct EpiConv {
    static constexpr bool PERM = true, AFTER_DRAIN = false;
    unsigned char* ws; const float* cw; const float* cb; PG8_LAS float* XB; int layer;
    __device__ __forceinline__ void operator()(f32x4 (&acc)[2][2][4][2], const Unit& u, int wr, int wc, int fr, int fq) const {
        int tl; { int t_ = threadIdx.x; asm volatile("" : "+v"(t_)); fr = t_ & 15; fq = (t_ >> 4) & 3; tl = t_; }
        PG8_LAS float* WL = XB + 2048;
        float wl0, wl1; { const int k0 = tl >> 7, k1 = k0 + 4, c = tl & 127; const unsigned cbase = (unsigned)(u.pn * HALF + c);
            wl0 = k0 < 3 ? cw[cbase + (unsigned)(k0 * 5632)] : cb[cbase];
            wl1 = k0 < 3 ? cw[cbase + (unsigned)(k0 * 5632 + 2816)] : cb[cbase + 2816u]; (void)k1; }
        const int cnd = u.pm < 32 ? 0 : 1 + ((u.pm - 32) >> 3); const bool lat = u.pm >= 32;
        const int ci0 = wc * 32 + 8 * fq, row0 = u.pm * BM + wr * 64 + fr;
        {
            const float* bias = (const float*)(ws + WS_B5) + ((size_t)layer * 3 + cnd) * 5632 + u.pn * BM + ci0;
            const float* rs0 = (const float*)(ws + WS_RS) + ((size_t)(2 * layer + 1) * 12288 + row0) * 4;
            float rstd[2][4];
#pragma unroll
            for (int ai = 0; ai < 2; ++ai) {
#pragma unroll
                for (int m = 0; m < 4; ++m) { const f32x4 p_ = *(const f32x4*)(rs0 + (ai * HALF + m * 16) * 4); rstd[ai][m] = __builtin_amdgcn_rsqf(((p_.x + p_.y) + (p_.z + p_.w)) * (1.f / 1024.f) + 1e-6f); }
                asm volatile("" : "+v"(rstd[ai][0]), "+v"(rstd[ai][1]), "+v"(rstd[ai][2]), "+v"(rstd[ai][3]) :: "memory");
            }
#pragma unroll
            for (int bj = 0; bj < 2; ++bj) {
                const f32x4 b0 = *(const f32x4*)(bias + bj * HALF), b1 = *(const f32x4*)(bias + bj * HALF + 4);
#pragma unroll
                for (int ai = 0; ai < 2; ++ai)
#pragma unroll
                    for (int m = 0; m < 4; ++m) { acc[ai][bj][m][0] = acc[ai][bj][m][0] * rstd[ai][m] + b0; acc[ai][bj][m][1] = acc[ai][bj][m][1] * rstd[ai][m] + b1; }
                asm volatile("" ::: "memory");
            }
        }
#pragma unroll
        for (int ai = 0; ai < 2; ++ai) { const int blk = 2 * ai + wr;
#pragma unroll
            for (int bj = 0; bj < 2; ++bj)
#pragma unroll
                for (int n = 0; n < 2; ++n) {
                    if (fr == 0) *(PG8_LAS f32x4*)(XB + (blk * 2 + 0) * 256 + bj * HALF + ci0 + 4 * n) = acc[ai][bj][0][n];
                    if (fr == 15) *(PG8_LAS f32x4*)(XB + (blk * 2 + 1) * 256 + bj * HALF + ci0 + 4 * n) = acc[ai][bj][3][n]; } }
        if (lat) { float* hb = (float*)(ws + WS_HALO) + (size_t)(u.pm - 32) * 4 * 5632 + u.pn * BM + ci0;
            if (wr == 0 && fr < 2) {
#pragma unroll
                for (int bj = 0; bj < 2; ++bj)
#pragma unroll
                    for (int n = 0; n < 2; ++n) *(f32x4*)(hb + (size_t)fr * 5632 + bj * HALF + 4 * n) = acc[0][bj][0][n]; }
            if (wr == 1 && fr >= 14) {
#pragma unroll
                for (int bj = 0; bj < 2; ++bj)
#pragma unroll
                    for (int n = 0; n < 2; ++n) *(f32x4*)(hb + (size_t)(fr - 12) * 5632 + bj * HALF + 4 * n) = acc[1][bj][3][n]; } }
        WL[tl] = wl0; WL[512 + tl] = wl1;
        asm volatile("s_waitcnt lgkmcnt(0)" ::: "memory"); __builtin_amdgcn_s_barrier(); asm volatile("" ::: "memory");
        const int ch0 = u.pn * HALF + ci0;
        bf16_t* actb = (bf16_t*)(ws + WS_ACT); const unsigned aoff0 = (unsigned)(row0 * 2816 + ch0);
#pragma unroll
        for (int n = 0; n < 2; ++n) {
#pragma unroll
            for (int ai = 0; ai < 2; ++ai) { const int blk = 2 * ai + wr;
#pragma unroll
                for (int bj = 0; bj < 2; ++bj) {
                    const PG8_LAS float* wlp = WL + bj * 512 + ci0 + 4 * n;
                    const f32x4 w0 = *(const PG8_LAS f32x4*)(wlp), w1 = *(const PG8_LAS f32x4*)(wlp + 128), w2 = *(const PG8_LAS f32x4*)(wlp + 256), bb = *(const PG8_LAS f32x4*)(wlp + 384);
                    f32x4 edge_prev = {0.f, 0.f, 0.f, 0.f}, edge_next = {0.f, 0.f, 0.f, 0.f};
                    if (blk > 0) edge_prev = *(const PG8_LAS f32x4*)(XB + ((blk - 1) * 2 + 1) * 256 + bj * HALF + ci0 + 4 * n);
                    if (blk < 3) edge_next = *(const PG8_LAS f32x4*)(XB + ((blk + 1) * 2 + 0) * 256 + bj * HALF + ci0 + 4 * n);
                    f32x4 orig = edge_prev;
#pragma unroll
                    for (int m = 0; m < 4; ++m) {
                        const f32x4 z = acc[ai][bj][m][n];
                        f32x4 pv = dpp4<0x121>(z), nx = dpp4<0x12F>(z);
                        const f32x4 e = m > 0 ? dpp4<0x121>(orig) : edge_prev;
                        const f32x4 g = m < 3 ? dpp4<0x12F>(acc[ai][bj][m < 3 ? m + 1 : 3][n]) : edge_next;
                        if (fr == 0) pv = e;
                        if (fr == 15) nx = g;
                        acc[ai][bj][m][n] = pv * w0 + z * w1 + nx * w2 + bb;
                        orig = z;
                    }
                    __builtin_amdgcn_sched_barrier(0); asm volatile("" ::: "memory");
                }
#pragma unroll
                for (int m = 0; m < 4; ++m) { const f32x4 av = acc[ai][0][m][n], gv = acc[ai][1][m][n]; f32x4 o;
#pragma unroll
                    for (int c = 0; c < 4; ++c) o[c] = av[c] * __builtin_amdgcn_rcpf(1.f + __expf(-av[c])) * gv[c];
                    typedef unsigned u32x2 __attribute__((ext_vector_type(2))); u32x2 w; w.x = cvt_pk_bf16(o[0], o[1]); w.y = cvt_pk_bf16(o[2], o[3]);
                    { unsigned ao_ = aoff0; asm volatile("" : "+v"(ao_)); *(u32x2*)(actb + (ao_ + (unsigned)((ai * HALF + m * 16) * 2816 + 4 * n))) = w; }
                }
                __builtin_amdgcn_sched_barrier(0); asm volatile("" ::: "memory");
            }
        }
    }
};
}

__device__ __forceinline__ void conv_fixup(unsigned char* ws, const float* cw, const float* cb, int pm, int tid) {
    const int lt = pm - 32, tq = lt & 7; const float* H = (const float*)(ws + WS_HALO); bf16* ACT = (bf16*)(ws + WS_ACT);
#pragma unroll
    for (int rep = 0; rep < 3; ++rep) { const int idx = tid + rep * NTHR;
        if (idx < 2 * (DFF / 4)) {
            const int which = idx >= DFF / 4, ch = (idx - which * (DFF / 4)) * 4;
            if (!((which == 0 && tq == 0) || (which == 1 && tq == 7))) {
                const int pa = (ch >> 7) * 256 + (ch & 127), pg = pa + 128;
                const float *zp, *zc, *zn;
                if (which == 0) { zp = H + (size_t)((lt - 1) * 4 + 3) * NUP; zc = H + (size_t)(lt * 4 + 0) * NUP; zn = H + (size_t)(lt * 4 + 1) * NUP; }
                else { zp = H + (size_t)(lt * 4 + 2) * NUP; zc = H + (size_t)(lt * 4 + 3) * NUP; zn = H + (size_t)((lt + 1) * 4 + 0) * NUP; }
                const f32x4 av = *(const f32x4*)(zp + pa) * *(const f32x4*)(cw + ch) + *(const f32x4*)(zc + pa) * *(const f32x4*)(cw + NUP + ch) + *(const f32x4*)(zn + pa) * *(const f32x4*)(cw + 2 * NUP + ch) + *(const f32x4*)(cb + ch);
                const f32x4 gv = *(const f32x4*)(zp + pg) * *(const f32x4*)(cw + DFF + ch) + *(const f32x4*)(zc + pg) * *(const f32x4*)(cw + NUP + DFF + ch) + *(const f32x4*)(zn + pg) * *(const f32x4*)(cw + 2 * NUP + DFF + ch) + *(const f32x4*)(cb + DFF + ch);
                f32x4 o;
#pragma unroll
                for (int c = 0; c < 4; ++c) o[c] = av[c] / (1.f + __expf(-av[c])) * gv[c];
                v2u w; w.x = pk2(o[0], o[1]); w.y = pk2(o[2], o[3]);
                *(v2u*)(ACT + (size_t)(pm * 256 + (which ? 255 : 0)) * DFF + ch) = w;
            }
        }
    }
    asm volatile("s_waitcnt vmcnt(0)" ::: "memory"); __syncthreads();
}

template <int W> __device__ __forceinline__ void pool_item(const bf16* U, bf16* AO, int r0, int ch) {
    constexpr int HW = W / 2, NR = 8 + W - 1;
    int s0, L; if (r0 < NCTX) { s0 = r0 & ~255; L = 256; } else { s0 = NCTX + ((r0 - NCTX) & ~2047); L = 2048; }
    const int t0 = r0 - s0;
    v4u x[NR];
#pragma unroll
    for (int i = 0; i < NR; ++i) { const int t = t0 - HW + i; x[i] = (v4u){0u, 0u, 0u, 0u}; if (t >= 0 && t < L) x[i] = *(const v4u*)(U + (size_t)(s0 + t) * 512 + ch * 8); }
#define PL_LO(V_) ((f32x4){bf_lo((V_).x), bf_hi((V_).x), bf_lo((V_).y), bf_hi((V_).y)})
#define PL_HI(V_) ((f32x4){bf_lo((V_).z), bf_hi((V_).z), bf_lo((V_).w), bf_hi((V_).w)})
    f32x4 s0v = {0.f, 0.f, 0.f, 0.f}, s1v = s0v;
#pragma unroll
    for (int i = 0; i < W; ++i) { s0v += PL_LO(x[i]); s1v += PL_HI(x[i]); }
#pragma unroll
    for (int i = 0; i < 8; ++i) {
        const int t = t0 + i; const float rc = 1.f / (float)(min(t + HW, L) - max(t - HW, 0));
        const f32x4 o0 = s0v * rc - PL_LO(x[i + HW]), o1 = s1v * rc - PL_HI(x[i + HW]);
        v4u o; o.x = pk2(o0.x, o0.y); o.y = pk2(o0.z, o0.w); o.z = pk2(o1.x, o1.y); o.w = pk2(o1.z, o1.w);
        *(v4u*)(AO + (size_t)(r0 + i) * 1024 + 512 + ch * 8) = o;
        if (i < 7) { s0v += PL_LO(x[i + W]) - PL_LO(x[i]); s1v += PL_HI(x[i + W]) - PL_HI(x[i]); }
    }
#undef PL_LO
#undef PL_HI
}
__device__ __forceinline__ void pool_phase(unsigned char* ws, int gtid, int NT_) {
    const bf16* U = (const bf16*)(ws + WS_U); bf16* AO = (bf16*)(ws + WS_AO);
    constexpr int PER_G = (M / 8) * 16;
    for (int it = gtid; it < 4 * PER_G; it += NT_) {
        const int g = it / PER_G, rem = it % PER_G, ch = g * 16 + (rem & 15), r0 = (rem >> 4) * 8;
        if (g == 0) pool_item<2>(U, AO, r0, ch); else if (g == 1) pool_item<4>(U, AO, r0, ch); else if (g == 2) pool_item<8>(U, AO, r0, ch); else pool_item<16>(U, AO, r0, ch);
    }
}

__device__ __forceinline__ void conv_phase(const Args& a, int l, int gtid, int NT_) {
    size_t wz_ = 0; asm volatile("" : "+s"(wz_)); unsigned char* ws = a.ws + wz_;     const bf16* Z = (const bf16*)(ws + WS_Z); bf16* ACT = (bf16*)(ws + WS_ACT);
    const float* cw = ain(a, I_CW) + (size_t)l * 3 * NUP; const float* cb = ain(a, I_CB) + (size_t)l * NUP;
    constexpr int NCH = DFF / 8, RUN = 8;
    for (int it = gtid; it < (M / RUN) * NCH; it += NT_) {
        const int ch = it % NCH, run = it / NCH, r0 = run * RUN, c0 = ch * 8;
        const int L = r0 < NCTX ? 256 : 2048; const int t0 = (r0 < NCTX ? r0 : r0 - NCTX) & (L - 1);
        v4u za[RUN + 2], zg[RUN + 2];
#pragma unroll
        for (int i = 0; i < RUN + 2; ++i) { const int t = t0 + i - 1; const bool ok = (t >= 0) && (t < L);
            const bf16* p = Z + (size_t)(r0 + i - 1) * NUP + c0;
            za[i] = (v4u){0u, 0u, 0u, 0u}; zg[i] = za[i];
            if (ok) { za[i] = *(const v4u*)p; zg[i] = *(const v4u*)(p + DFF); } }
        f32x4 wa[3][2], wg[3][2], ba[2], bg[2];
#pragma unroll
        for (int k = 0; k < 3; ++k)
#pragma unroll
            for (int q = 0; q < 2; ++q) { wa[k][q] = *(const f32x4*)(cw + (size_t)k * NUP + c0 + 4 * q); wg[k][q] = *(const f32x4*)(cw + (size_t)k * NUP + DFF + c0 + 4 * q); }
#pragma unroll
        for (int q = 0; q < 2; ++q) { ba[q] = *(const f32x4*)(cb + c0 + 4 * q); bg[q] = *(const f32x4*)(cb + DFF + c0 + 4 * q); }
#define CV_LO(V_) ((f32x4){bf_lo((V_).x), bf_hi((V_).x), bf_lo((V_).y), bf_hi((V_).y)})
#define CV_HI(V_) ((f32x4){bf_lo((V_).z), bf_hi((V_).z), bf_lo((V_).w), bf_hi((V_).w)})
#pragma unroll
        for (int i = 0; i < RUN; ++i) {
            const f32x4 a0 = CV_LO(za[i]) * wa[0][0] + CV_LO(za[i + 1]) * wa[1][0] + CV_LO(za[i + 2]) * wa[2][0] + ba[0];
            const f32x4 a1 = CV_HI(za[i]) * wa[0][1] + CV_HI(za[i + 1]) * wa[1][1] + CV_HI(za[i + 2]) * wa[2][1] + ba[1];
            const f32x4 g0 = CV_LO(zg[i]) * wg[0][0] + CV_LO(zg[i + 1]) * wg[1][0] + CV_LO(zg[i + 2]) * wg[2][0] + bg[0];
            const f32x4 g1 = CV_HI(zg[i]) * wg[0][1] + CV_HI(zg[i + 1]) * wg[1][1] + CV_HI(zg[i + 2]) * wg[2][1] + bg[1];
            f32x4 o0, o1;
#pragma unroll
            for (int c = 0; c < 4; ++c) { o0[c] = a0[c] * __builtin_amdgcn_rcpf(1.f + __expf(-a0[c])) * g0[c]; o1[c] = a1[c] * __builtin_amdgcn_rcpf(1.f + __expf(-a1[c])) * g1[c]; }
            v4u ov; ov.x = pk2(o0.x, o0.y); ov.y = pk2(o0.z, o0.w); ov.z = pk2(o1.x, o1.y); ov.w = pk2(o1.z, o1.w);
            *(v4u*)(ACT + (size_t)(r0 + i) * DFF + c0) = ov;
        }
#undef CV_LO
#undef CV_HI
    }
}
#define XB_TMO      128
#define XB_XCNT(j)  (256  + 64 * (j))
#define XB_XSUB(j)  (1280 + 64 * (j))
#define XB_XGEN(j)  (2304 + 64 * (j))
#define XB_TOP      3328
#define XB_TOPGEN   3392
#define XCD_BAR_WORDS 3456
#define XB_SPIN_CAP (1u << 18)

__device__ __forceinline__ unsigned xb_ld(unsigned* p)              { return __hip_atomic_load(p, __ATOMIC_RELAXED, __HIP_MEMORY_SCOPE_AGENT); }
__device__ __forceinline__ unsigned xb_add(unsigned* p, unsigned v) { return __hip_atomic_fetch_add(p, v, __ATOMIC_RELAXED, __HIP_MEMORY_SCOPE_AGENT); }
__device__ __forceinline__ unsigned xb_xcc_id() { return (unsigned)__builtin_amdgcn_s_getreg((3 << 11) | 20) & 0xFu; }
#define XB_SPIN(cond, bar) do { unsigned _sp = 0; while (cond) { __builtin_amdgcn_s_sleep(1); \
    if ((++_sp & 255u) == 0u) { if (xb_ld(&(bar)[XB_TMO])) break; if (_sp > XB_SPIN_CAP) { atomicAdd(&(bar)[XB_TMO], 1u); break; } } } } while (0)

struct XcdBarrier {
    unsigned* bar; unsigned x;
    volatile LAS unsigned* st;
};

__device__ __forceinline__ XcdBarrier xcd_barrier_post(unsigned* bar, volatile LAS unsigned* st) {
    XcdBarrier b; b.bar = bar; b.x = xb_xcc_id(); b.st = st;
    if (threadIdx.x == 0) (void)xb_add(&bar[XB_XCNT(b.x)], 1u);
    return b;
}
__device__ __forceinline__ void xcd_barrier_complete(unsigned* bar, unsigned x, unsigned& nloc, unsigned& nx) {
    const unsigned G = gridDim.x * gridDim.y * gridDim.z;
    unsigned sum, cnt, mine, sp = 0u;
    for (;;) {
        sum = 0u; cnt = 0u; mine = 0u;
#pragma unroll
        for (unsigned j = 0; j < 16; ++j) { const unsigned c = xb_ld(&bar[XB_XCNT(j)]); sum += c; cnt += (c > 0u) ? 1u : 0u; mine = (j == x) ? c : mine; }
        if (sum == G) break;
        __builtin_amdgcn_s_sleep(1);
        if ((++sp & 255u) == 0u) { if (xb_ld(&bar[XB_TMO])) break; if (sp > XB_SPIN_CAP) { atomicAdd(&bar[XB_TMO], 1u); break; } }
    }
    nloc = mine > 0u ? mine : 1u; nx = cnt > 0u ? cnt : 1u;
}

__device__ __forceinline__ void xcd_barrier(const XcdBarrier& b) {
    asm volatile("s_waitcnt vmcnt(0)" ::: "memory");
    __syncthreads();
    if (threadIdx.x == 0) {
        unsigned* bar = b.bar;
        __builtin_amdgcn_s_waitcnt(0);
        unsigned nloc = b.st[0], nx = b.st[1];
        if (nloc == 0u) { xcd_barrier_complete(bar, b.x, nloc, nx); b.st[0] = nloc; b.st[1] = nx; }
        const unsigned old = xb_add(&bar[XB_XSUB(b.x)], 1u);
        const unsigned gen = old / nloc;
        if (old + 1u == (gen + 1u) * nloc) {
            __builtin_amdgcn_fence(__ATOMIC_RELEASE, "agent");
            asm volatile("s_waitcnt vmcnt(0)" ::: "memory");
            const unsigned og = xb_add(&bar[XB_TOP], 1u);
            const unsigned tg = og / nx;
            if (og + 1u == (tg + 1u) * nx) xb_add(&bar[XB_TOPGEN], 1u);
            else XB_SPIN(xb_ld(&bar[XB_TOPGEN]) == tg, bar);
            __builtin_amdgcn_fence(__ATOMIC_ACQUIRE, "agent");
            xb_add(&bar[XB_XGEN(b.x)], 1u);
            asm volatile("s_waitcnt vmcnt(0)" ::: "memory");
        } else {
            XB_SPIN(xb_ld(&bar[XB_XGEN(b.x)]) == gen, bar);
            __builtin_amdgcn_fence(__ATOMIC_ACQUIRE, "agent");
            asm volatile("s_waitcnt vmcnt(0)" ::: "memory");
        }
    }
    __syncthreads();
}

#ifdef SKIP0
#define SK0(...) do{}while(0)
#else
#define SK0(...) __VA_ARGS__
#endif
#ifdef SKIP1
#define SK1(...) do{}while(0)
#else
#define SK1(...) __VA_ARGS__
#endif
#ifdef SKIP2
#define SK2(...) do{}while(0)
#else
#define SK2(...) __VA_ARGS__
#endif
#ifdef SKIP3
#define SK3(...) do{}while(0)
#else
#define SK3(...) __VA_ARGS__
#endif
#ifdef SKIP4
#define SK4(...) do{}while(0)
#else
#define SK4(...) __VA_ARGS__
#endif
#ifdef SKIP5
#define SK5(...) do{}while(0)
#else
#define SK5(...) __VA_ARGS__
#endif
constexpr int NPH_L = 5;
constexpr int NPHASE = 2 + NPH_L * DEPTH + 1;
__global__ void __launch_bounds__(NTHR, 2) mega_fwd(Args a) {
    extern __shared__ __attribute__((aligned(16))) unsigned char lds_raw[];
    cg::grid_group grid = cg::this_grid();
    LAS unsigned char* lds = (LAS unsigned char*)lds_raw;
    volatile LAS unsigned* bst = (volatile LAS unsigned*)(lds + 131072 + 64);
    if (threadIdx.x < 2) bst[threadIdx.x] = 0u;
    __syncthreads();
    XcdBarrier xbar = xcd_barrier_post((unsigned*)a.ws, bst);
#ifdef PROBE_DUP
    for (int ph2 = 2 * a.ph_lo; ph2 < 2 * a.ph_hi; ++ph2) {
        const int ph = ph2 >> 1;
        if ((ph2 & 1) && !(ph >= 2 && ph < NPHASE - 1 && (ph - 2) % NPH_L == PROBE_DUP)) continue;
#else
    for (int ph = a.ph_lo; ph < a.ph_hi; ++ph) {
#endif
        int G = gridDim.x, bx = blockIdx.x; asm volatile("" : "+s"(G), "+s"(bx));
        const int vcu = (G % 8 == 0) ? (bx % 8) * (G / 8) + bx / 8 : bx;
        const int NGW = G * NWAVES, NGT = G * NTHR;
        const int n_idle = G - 192; const bool defer = n_idle >= 32; const int nl_pre = defer ? 1 : DEPTH;
#define TIDS() int tid = threadIdx.x; asm volatile("" : "+v"(tid)); const int lane = tid & 63, wave = __builtin_amdgcn_readfirstlane(tid >> 6); const int gw = vcu * NWAVES + wave, gtid = vcu * NTHR + tid; (void)lane; (void)gw; (void)gtid
        size_t wz_ = 0; asm volatile("" : "+s"(wz_)); unsigned char* ws = a.ws + wz_;
        float* mod = (float*)(ws + WS_MOD);
        if (ph == 0) { TIDS(); SK0(prologue(a, lds, vcu, G, tid, lane, wave, nl_pre)); }
        else if (ph == 1) { TIDS(); phase1(a, gw, NGW, lane, nl_pre); }
        else if (ph == NPHASE - 1) { TIDS(); final_norm(a, gw, NGW, lane); }
        else {
            const int l = (ph - 2) / NPH_L, s = (ph - 2) % NPH_L;
            if (s == 0) {
                pg8::Gemm g{(const pg8::bf16_t*)(ws + WS_H), (const pg8::bf16_t*)(ws + WS_WIN) + (size_t)l * NIN * D, M, NIN, D};
                pg8::StaticOrder S; S.init(M, NIN, G, bx);
                pg8::EpiQKV E{ws, a.out, ain(a, I_QG) + l * 64, ain(a, I_KG) + l * 64, l};
                SK1(pg8::gemm_phase<pg8::EpiQKV, pg8::StaticOrder, true, true>(lds, g, S, E));
            } else if (s == 1) {
                TIDS();
#ifndef ATT_SPLIT
                pool_phase(ws, gtid, NGT);
                const attn_body::bf16* Qb = (const attn_body::bf16*)(ws + WS_Q); attn_body::bf16* AOb = (attn_body::bf16*)(ws + WS_AO);
                for (int idx = vcu; idx < 512; idx += G) {
                    const attn_body::bf16 *Q0, *Kh, *Vh; attn_body::bf16* O0; int NT, ncomp;
                    if (idx < 256) { const int b = idx >> 7, h = (idx >> 4) & 7, qb = idx & 15; const size_t r0 = (size_t)NCTX + b * LSEQ + qb * 128;
                        Q0 = Qb + r0 * 512 + h * 64; O0 = AOb + r0 * 1024 + h * 64; NT = LKEYS / 64; ncomp = 4;
                        Kh = (const attn_body::bf16*)(ws + WS_KL) + ((size_t)(l * 2 + b) * LKEYS) * 128 + (h >> 2) * 64;
                        Vh = (const attn_body::bf16*)(ws + WS_VL) + ((size_t)(l * 2 + b) * LKEYS) * 128 + (h >> 2) * 64;
                    } else { const int u = idx - 256, b = u >> 3, h = u & 7; const size_t r0 = (size_t)b * SEQ;
                        Q0 = Qb + r0 * 512 + h * 64; O0 = AOb + r0 * 1024 + h * 64; NT = SEQ / 64; ncomp = 8;
                        Kh = (const attn_body::bf16*)(ws + WS_KC) + r0 * 128 + (h >> 2) * 64;
                        Vh = (const attn_body::bf16*)(ws + WS_VC) + r0 * 128 + (h >> 2) * 64; }
                    SK2(attn_body::attn_unit<8>(Q0, Kh, Vh, O0, NT, (char*)lds_raw, 0, nullptr, nullptr, nullptr, ncomp));
                }
#else
                pool_phase(ws, gtid, NGT);
                const attn_body::bf16* Qb = (const attn_body::bf16*)(ws + WS_Q); attn_body::bf16* AOb = (attn_body::bf16*)(ws + WS_AO);
                for (int idx = vcu; idx < 512; idx += G) {
                    const attn_body::bf16 *Q0, *Kh, *Vh; attn_body::bf16* O0; int NT, split = 0; float* part = nullptr; const float* partner = nullptr; unsigned* cnt = nullptr;
                    if (idx < 256) { const int un = idx >> 1, hf = idx & 1, b = un >> 6, h = (un >> 3) & 7, qb = un & 7; const size_t r0 = (size_t)NCTX + b * LSEQ + qb * 256;
                        Q0 = Qb + r0 * 512 + h * 64; O0 = AOb + r0 * 1024 + h * 64; NT = LKEYS / 128; split = 1;
                        Kh = (const attn_body::bf16*)(ws + WS_KL) + ((size_t)(l * 2 + b) * LKEYS + hf * (LKEYS / 2)) * 128 + (h >> 2) * 64;
                        Vh = (const attn_body::bf16*)(ws + WS_VL) + ((size_t)(l * 2 + b) * LKEYS + hf * (LKEYS / 2)) * 128 + (h >> 2) * 64;
                        part = (float*)(ws + WS_APART) + (size_t)idx * APART_FLOATS; partner = (const float*)(ws + WS_APART) + (size_t)(idx ^ 1) * APART_FLOATS;
                        cnt = (unsigned*)(ws + WS_ACNT) + ((size_t)l * 128 + un) * 8;
                    } else { const int u = idx - 256, b = u >> 3, h = u & 7; const size_t r0 = (size_t)b * SEQ;
                        Q0 = Qb + r0 * 512 + h * 64; O0 = AOb + r0 * 1024 + h * 64; NT = SEQ / 64;
                        Kh = (const attn_body::bf16*)(ws + WS_KC) + r0 * 128 + (h >> 2) * 64;
                        Vh = (const attn_body::bf16*)(ws + WS_VC) + r0 * 128 + (h >> 2) * 64; }
                    SK2(attn_body::attn_unit<8>(Q0, Kh, Vh, O0, NT, (char*)lds_raw, split, part, partner, cnt, 8));
                }
#endif
            } else if (s == 2 || s == 4) {
                const bool dn = (s == 4);
                pg8::Gemm g{(const pg8::bf16_t*)(ws + (dn ? WS_ACT : WS_AO)), dn ? (const pg8::bf16_t*)(ws + WS_WDN) + (size_t)l * D * DFF : (const pg8::bf16_t*)(ws + WS_WOUT) + (size_t)l * D * D, M, D, dn ? DFF : D};
                pg8::StaticOrder S; S.init(M, D, G, bx);
                if (defer && bx >= 192) {
                    TIDS(); const int iw = (bx - 192) * NWAVES + wave, NIW = n_idle * NWAVES;
                    if (!dn) { if (l + 1 < DEPTH) convert_layer(a, ws, lds, iw, NIW, lane, wave, l + 1, 0);
                               if (l >= 1) bias_rows(ws, iw, NIW, lane, l, true); }
                    else if (l + 1 < DEPTH) { convert_layer(a, ws, lds, iw, NIW, lane, wave, l + 1, 1); weff_layer(a, ws, lds, iw, NIW, lane, wave, l + 1);
                                              bias_rows(ws, iw, NIW, lane, l + 1, false); }
                }
                if (dn) { TIDS(); pg8::Unit u0; if (S.next(0, u0) && u0.pm >= 32) conv_fixup(ws, ain(a, I_CW) + (size_t)l * 3 * NUP, ain(a, I_CB) + (size_t)l * NUP, u0.pm, tid); }
                pg8::EpiRes E{ws, mod + (size_t)l * 3 * NMOD + (dn ? 5 : 2) * D, dn ? (l + 1 < DEPTH ? 2 * (l + 1) : -1) : 2 * l + 1, (PG8_LAS float*)(lds + 131072 + 1024)};
#ifdef PROBE_DUP
                if (ph2 & 1) E.ninst = -2;
#endif
                SK3(pg8::gemm_phase<pg8::EpiRes, pg8::StaticOrder, true, true>(lds, g, S, E));
            } else {
                pg8::Gemm g{(const pg8::bf16_t*)(ws + WS_H), (const pg8::bf16_t*)(ws + WS_WUP) + (size_t)l * NUP * D, M, NUP, D};
                pg8::StaticOrder S; S.init(M, NUP, G, bx);
                pg8::EpiConv E{ws, ain(a, I_CW) + (size_t)l * 3 * NUP, ain(a, I_CB) + (size_t)l * NUP, (PG8_LAS float*)(lds + 131072 + 1024), l};
                SK4(pg8::gemm_phase<pg8::EpiConv, pg8::StaticOrder, true, true>(lds, g, S, E));
            }
        }
#ifdef PROBE_DUP
        if (ph2 + 1 < 2 * a.ph_hi) {
#else
        if (ph + 1 < a.ph_hi) {
#endif: the first one is cg grid.sync() (marks the kernel cooperative for the replay), the rest the XCD-aware barrier
            if (a.ph_hi < 0) grid.sync();
            xcd_barrier(xbar);
#ifdef PROBE_SYNC2
            xcd_barrier(xbar);
#endif
        }
    }
}

#ifndef MK_MULTI
#define MK_MULTI 0
#endif
extern "C" void kernel_launch(void* const* d_in, const int* in_sizes, int n_in, void* d_out, int out_size, void* d_ws, size_t ws_size, hipStream_t stream) {
    static int grid = 0;
    if (grid == 0) {
        if (n_in != 21 || ws_size < WS_END) { fprintf(stderr, "kernel_launch: unexpected n_in %d / ws_size %zu\n", n_in, ws_size); grid = -1; return; }
        int dev = 0, cus = 0, per_cu = 0;
        hipGetDevice(&dev); hipDeviceGetAttribute(&cus, hipDeviceAttributeMultiprocessorCount, dev);
        if (hipFuncSetAttribute((const void*)mega_fwd, hipFuncAttributeMaxDynamicSharedMemorySize, LDS_BYTES) != hipSuccess) { fprintf(stderr, "kernel_launch: hipFuncSetAttribute failed\n"); grid = -1; return; }
        if (hipOccupancyMaxActiveBlocksPerMultiprocessor(&per_cu, (const void*)mega_fwd, NTHR, LDS_BYTES) != hipSuccess || per_cu < 1) { fprintf(stderr, "kernel_launch: occupancy query says %d\n", per_cu); (void)hipGetLastError(); grid = -1; return; }
        grid = cus * per_cu;
        fprintf(stderr, "kernel_launch: grid %d (cus %d x %d)\n", grid, cus, per_cu);
    }
    if (grid < 0) return;
    Args a{};
    for (int i = 0; i < 21; ++i) a.in[i] = (const float*)d_in[i];
    a.out = (float*)d_out; a.ws = (unsigned char*)d_ws;
#if MK_MULTI
    for (int ph = 0; ph < NPHASE; ++ph) { a.ph_lo = ph; a.ph_hi = ph + 1; hipLaunchKernelGGL(mega_fwd, dim3(grid), dim3(NTHR), LDS_BYTES, stream, a); }
#else
    a.ph_lo = 0; a.ph_hi = NPHASE;
    if (hipMemsetAsync(d_ws, 0, 16384, stream) != hipSuccess) { fprintf(stderr, "kernel_launch: memset failed\n"); return; }
    void* args[] = {&a};
    hipError_t e = hipLaunchCooperativeKernel((const void*)mega_fwd, dim3(grid), dim3(NTHR), args, LDS_BYTES, stream);
    if (e != hipSuccess) fprintf(stderr, "cooperative launch failed: %s (grid %d)\n", hipGetErrorString(e), grid);
#endif
}
```

```cpp
#include <hip/hip_runtime.h>
#include <hip/hip_cooperative_groups.h>
#include <cstdio>
#include <cstdint>
namespace cg = cooperative_groups;
#define MK_MULTI 0
namespace pg8 {
#define PG8_LAS __attribute__((address_space(3)))
typedef unsigned short bf16_t;
typedef short bf16x8 __attribute__((ext_vector_type(8)));
typedef float f32x4 __attribute__((ext_vector_type(4)));
typedef unsigned u32x4 __attribute__((ext_vector_type(4)));
constexpr int BM = 256, BK = 64, HALF = 128, HTB = HALF * BK * 2  , STAGE_BYTES = 8 * HTB, NXCD = 8, WGM = 6;

__host__ __device__ __forceinline__ int lds_byte(int r, int c) { const int st = (r >> 4) * 2 + (c >> 5), rr = r & 15, cc = c & 31, ob = rr * 64 + cc * 2; return st * 1024 + (ob ^ (((ob >> 9) & 1) << 5)); }
__host__ __device__ __forceinline__ void stage_rc(int b, int& R, int& C) { const int st = b / 1024, sb = b % 1024, swz = sb ^ (((sb >> 9) & 1) << 5); R = (st >> 1) * 16 + swz / 64; C = (st & 1) * 32 + (swz % 64) / 2; }
__host__ __device__ __forceinline__ int perm32(int rho) { const int n = rho >> 4, i = rho & 15; return 8 * (i >> 2) + 4 * n + (i & 3); }

struct Unit { int pm, pn; };
struct Gemm { const bf16_t* A; const bf16_t* Bt; int M, N, K; };

struct StaticOrder {
    int nM, nN, nwg, G, c;
    __host__ __device__ void init(int M, int N, int G_, int c_) { nM = M / BM; nN = N / BM; nwg = nM * nN; G = G_; c = c_; }
    __host__ __device__ bool next(int i, Unit& u) const {
        const long L = (long)i * G + c; if (L >= nwg) return false;
        int wgid = (int)L; { const int q = nwg / NXCD, r = nwg % NXCD, xcd = wgid % NXCD, off = wgid / NXCD; wgid = (xcd < r ? xcd * (q + 1) : r * (q + 1) + (xcd - r) * q) + off; }
        const int nig = WGM * nN, gid = wgid / nig, fm = gid * WGM, gsz = (nM - fm) < WGM ? (nM - fm) : WGM;
        u.pm = fm + ((wgid % nig) % gsz); u.pn = (wgid % nig) / gsz; return true;
    }
    __device__ __forceinline__ void a_ready(const Unit&) const {}
    __device__ __forceinline__ void done(const Unit&) const {}
};

__device__ __forceinline__ unsigned cvt_pk_bf16(float lo, float hi) { unsigned r; asm volatile("v_cvt_pk_bf16_f32 %0, %1, %2" : "=v"(r) : "v"(lo), "v"(hi)); return r; }
typedef float f32x2 __attribute__((ext_vector_type(2)));
__device__ __forceinline__ f32x2 gelu_pk(f32x2 v) {
    const f32x2 av = __builtin_elementwise_abs(v), d = av * 0.2316418882f + 1.0f;
    f32x2 t; t.x = __builtin_amdgcn_rcpf(d.x); t.y = __builtin_amdgcn_rcpf(d.y);
    f32x2 q = t * 0.5307027145f + (-0.7265760135f); q = q * t + 0.7107068705f; q = q * t + (-0.142248368f); q = q * t + 0.127414796f; q = q * t;
    const f32x2 s = (v * v) * (-0.72134752044f);
    f32x2 e; e.x = __builtin_amdgcn_exp2f(s.x); e.y = __builtin_amdgcn_exp2f(s.y);
    const f32x2 m = v * (q * e), r = v - m;
    f32x2 o; o.x = v.x < 0.f ? m.x : r.x; o.y = v.y < 0.f ? m.y : r.y; return o;
}

template <int ACT  > struct EpiBf16 {
    static constexpr bool PERM = true, AFTER_DRAIN = false; static_assert(ACT == 0 || ACT == 1, "EpiBf16: ACT is 0 (none) or 1 (gelu_pk)");
    bf16_t* O; int ldc; const float* bias; int split_cols; size_t split_stride; float scale0;
    __device__ __forceinline__ void operator()(const f32x4 (&acc)[2][2][4][2], const Unit& u, int wr, int wc, int fr, int fq) const {
        const int row0 = u.pm * BM + wr * 64 + fr; int colt = u.pn * BM; bf16_t* base = O;
        float sc = 1.f; if (split_cols) { const int t = colt / split_cols; base += (size_t)t * split_stride; colt -= t * split_cols; if (t == 0) sc = scale0; }
        const int col0 = colt + wc * 32 + 8 * fq, bcol0 = u.pn * BM + wc * 32 + 8 * fq;
        f32x4 bv[2][2];
#pragma unroll
        for (int bj = 0; bj < 2; ++bj)
#pragma unroll
            for (int n = 0; n < 2; ++n) bv[bj][n] = bias ? *(const f32x4*)(bias + bcol0 + bj * HALF + 4 * n) : (f32x4){0.f, 0.f, 0.f, 0.f};
#pragma unroll
        for (int ai = 0; ai < 2; ++ai)
#pragma unroll
            for (int m = 0; m < 4; ++m) { bf16_t* rowp = base + (size_t)(row0 + ai * HALF + m * 16) * ldc + col0;
#pragma unroll
                for (int bj = 0; bj < 2; ++bj) { f32x4 v0 = acc[ai][bj][m][0] + bv[bj][0], v1 = acc[ai][bj][m][1] + bv[bj][1];
                    if (ACT == 1) { f32x2 a = gelu_pk((f32x2){v0[0], v0[1]}), b = gelu_pk((f32x2){v0[2], v0[3]}), c = gelu_pk((f32x2){v1[0], v1[1]}), d = gelu_pk((f32x2){v1[2], v1[3]});
                        v0 = (f32x4){a.x, a.y, b.x, b.y}; v1 = (f32x4){c.x, c.y, d.x, d.y}; }
                    v0 = v0 * sc; v1 = v1 * sc; u32x4 w; w.x = cvt_pk_bf16(v0[0], v0[1]); w.y = cvt_pk_bf16(v0[2], v0[3]); w.z = cvt_pk_bf16(v1[0], v1[1]); w.w = cvt_pk_bf16(v1[2], v1[3]);
                    *(u32x4*)(rowp + bj * HALF) = w; } }
    }
};
template <class Epi, class Sched, bool ALIGN_EPI = false, bool SP2 = false>
__device__ __forceinline__ void gemm_phase(PG8_LAS unsigned char* lds, const Gemm g, const Sched& S, const Epi& E) {
    int tid_ = threadIdx.x; asm volatile("" : "+v"(tid_));
    const int tid = tid_, wid = __builtin_amdgcn_readfirstlane(tid >> 6), lane = tid & 63, wr = wid >> 2, wc = wid & 3, fr = lane & 15, fq = lane >> 4;
    const int K = g.K, nt = K / BK;
    unsigned voffA[2], voffB[2];
#pragma unroll
    for (int i = 0; i < 2; ++i) { int R, C; stage_rc(tid * 16 + i * 8192, R, C); const int Rb = Epi::PERM ? ((R & ~31) + perm32(R & 31)) : R;
        voffA[i] = (unsigned)(R * K + C) * 2u; voffB[i] = (unsigned)(Rb * K + C) * 2u; }
    const size_t kstep = (size_t)(BK * 2);
    const size_t hstep = (size_t)HALF * K * 2;
    const size_t tstep = 2 * hstep;
    const unsigned ldsw = (unsigned)wid * 1024u;
    const int aoff = lds_byte(wr * 64 + fr, fq * 8), boff = lds_byte(wc * 32 + fr, fq * 8);
#define PG8_SA(b, h) (((b) * 2 + (h)) * HTB)
#define PG8_SB(b, h) ((4 + (b) * 2 + (h)) * HTB)
#define PG8_STAGE(bufoff, gbase, voff) do { _Pragma("unroll") for (int _i = 0; _i < 2; ++_i) \
        __builtin_amdgcn_global_load_lds((const unsigned*)((const char*)(gbase) + (voff)[_i]), (PG8_LAS unsigned*)(lds + (bufoff) + ldsw + _i * 8192), 16, 0, 0); } while (0)
#define PG8_LDA(dst, b, h) do { _Pragma("unroll") for (int m = 0; m < 4; ++m) _Pragma("unroll") for (int k = 0; k < 2; ++k) dst[m][k] = *(const PG8_LAS bf16x8*)(lds + PG8_SA(b, h) + aoff + m * 2048 + k * 1024); } while (0)
#define PG8_LDB(dst, b, h) do { _Pragma("unroll") for (int n = 0; n < 2; ++n) _Pragma("unroll") for (int k = 0; k < 2; ++k) dst[n][k] = *(const PG8_LAS bf16x8*)(lds + PG8_SB(b, h) + boff + n * 2048 + k * 1024); } while (0)
#define PG8_MMA(ai, bj, At, Bt) do { __builtin_amdgcn_s_setprio(1); _Pragma("unroll") for (int m = 0; m < 4; ++m) _Pragma("unroll") for (int n = 0; n < 2; ++n) _Pragma("unroll") for (int k = 0; k < 2; ++k) \
        acc[ai][bj][m][n] = __builtin_amdgcn_mfma_f32_16x16x32_bf16(Bt[n][k], At[m][k], acc[ai][bj][m][n], 0, 0, 0); __builtin_amdgcn_s_setprio(0); } while (0)
#define PG8_WAIT_V(n) asm volatile("s_waitcnt vmcnt(" #n ")" ::: "memory")
#define PG8_WAIT_L(n) asm volatile("s_waitcnt lgkmcnt(" #n ")" ::: "memory")
#define PG8_BAR __builtin_amdgcn_s_barrier()
#define PG8_SCHED __builtin_amdgcn_sched_barrier(0)
    Unit cur, nxt; int ui = 0;
    if (!S.next(0, cur)) return;
    f32x4 acc[2][2][4][2];
#pragma unroll
    for (int a = 0; a < 2; ++a)
#pragma unroll
        for (int b = 0; b < 2; ++b)
#pragma unroll
            for (int m = 0; m < 4; ++m)
#pragma unroll
                for (int n = 0; n < 2; ++n) acc[a][b][m][n] = (f32x4){0.f, 0.f, 0.f, 0.f};
    bf16x8 At[4][2], B0[2][2], B1[2][2];
    const char* cA = (const char*)g.A + (size_t)cur.pm * tstep; const char* cB = (const char*)g.Bt + (size_t)cur.pn * tstep;
    S.a_ready(cur);
    if constexpr (SP2) {
        PG8_STAGE(PG8_SB(0, 0), cB, voffB); PG8_STAGE(PG8_SB(0, 1), cB + hstep, voffB); PG8_STAGE(PG8_SA(0, 0), cA, voffA); PG8_STAGE(PG8_SA(0, 1), cA + hstep, voffA);
        if (wr == 1) PG8_BAR;
        PG8_WAIT_V(2); PG8_BAR;
        PG8_STAGE(PG8_SB(1, 0), cB + kstep, voffB); PG8_STAGE(PG8_SA(1, 0), cA + kstep, voffA); PG8_STAGE(PG8_SB(1, 1), cB + hstep + kstep, voffB);
        PG8_WAIT_V(6); PG8_BAR;
    } else {
        PG8_STAGE(PG8_SB(0, 0), cB, voffB); PG8_STAGE(PG8_SA(0, 0), cA, voffA); PG8_STAGE(PG8_SB(0, 1), cB + hstep, voffB); PG8_STAGE(PG8_SA(0, 1), cA + hstep, voffA);
        if (wr == 1) PG8_BAR;
        PG8_WAIT_V(4); PG8_BAR;
        PG8_STAGE(PG8_SB(1, 0), cB + kstep, voffB); PG8_STAGE(PG8_SA(1, 0), cA + kstep, voffA); PG8_STAGE(PG8_SB(1, 1), cB + hstep + kstep, voffB);
        PG8_WAIT_V(6); PG8_BAR;
    }
    for (;;) {
        const bool has_next = S.next(ui + 1, nxt);
        const char* nA = has_next ? (const char*)g.A + (size_t)nxt.pm * tstep : cA; const char* nB = has_next ? (const char*)g.Bt + (size_t)nxt.pn * tstep : cB;
        for (int t = 0; t < nt; t += 2) {
            const bool last = (t == nt - 2);
            const char* a1 = cA + (size_t)(t + 1) * kstep;
            const char* a2 = last ? nA : cA + (size_t)(t + 2) * kstep; const char* b2 = last ? nB : cB + (size_t)(t + 2) * kstep;
            const char* a3 = a2 + kstep; const char* b3 = b2 + kstep;
            if (last && has_next) S.a_ready(nxt);
            if constexpr (SP2) {
            PG8_LDB(B0, 0, 0); PG8_LDB(B1, 0, 1); PG8_SCHED; PG8_LDA(At, 0, 0); PG8_STAGE(PG8_SA(1, 1), a1 + hstep, voffA);
            PG8_WAIT_V(8); PG8_WAIT_L(0); PG8_BAR; PG8_MMA(0, 0, At, B0); PG8_MMA(0, 1, At, B1); PG8_BAR; PG8_SCHED;
            PG8_LDA(At, 0, 1); PG8_STAGE(PG8_SB(0, 0), b2, voffB); PG8_STAGE(PG8_SB(0, 1), b2 + hstep, voffB); PG8_STAGE(PG8_SA(0, 0), a2, voffA);
            PG8_WAIT_V(8); PG8_WAIT_L(0); PG8_BAR; PG8_MMA(1, 0, At, B0); PG8_MMA(1, 1, At, B1); PG8_BAR; PG8_SCHED;
            PG8_LDB(B0, 1, 0); PG8_LDB(B1, 1, 1); PG8_SCHED; PG8_LDA(At, 1, 0); PG8_STAGE(PG8_SA(0, 1), a2 + hstep, voffA);
            PG8_WAIT_V(8); PG8_WAIT_L(0); PG8_BAR; PG8_MMA(0, 0, At, B0); PG8_MMA(0, 1, At, B1); PG8_BAR; PG8_SCHED;
            PG8_LDA(At, 1, 1); PG8_STAGE(PG8_SB(1, 0), b3, voffB); PG8_STAGE(PG8_SB(1, 1), b3 + hstep, voffB); PG8_STAGE(PG8_SA(1, 0), a3, voffA);
            PG8_WAIT_V(8); PG8_WAIT_L(0); PG8_BAR; PG8_MMA(1, 0, At, B0); PG8_MMA(1, 1, At, B1); PG8_BAR; PG8_SCHED;
            } else {
            PG8_LDB(B0, 0, 0); PG8_SCHED; PG8_LDA(At, 0, 0); PG8_STAGE(PG8_SA(1, 1), a1 + hstep, voffA);
            PG8_WAIT_L(8); PG8_BAR; PG8_WAIT_L(0); PG8_MMA(0, 0, At, B0); PG8_BAR; PG8_SCHED;
            PG8_LDB(B1, 0, 1); PG8_STAGE(PG8_SB(0, 0), b2, voffB);
            PG8_BAR; PG8_WAIT_L(0); PG8_MMA(0, 1, At, B1); PG8_BAR;
            PG8_LDA(At, 0, 1); PG8_STAGE(PG8_SA(0, 0), a2, voffA);
            PG8_BAR; PG8_WAIT_L(0); PG8_MMA(1, 0, At, B0); PG8_BAR; PG8_SCHED;
            PG8_STAGE(PG8_SB(0, 1), b2 + hstep, voffB);
            PG8_WAIT_V(6); PG8_BAR; PG8_MMA(1, 1, At, B1); PG8_BAR;
            PG8_LDB(B0, 1, 0); PG8_SCHED; PG8_LDA(At, 1, 0); PG8_STAGE(PG8_SA(0, 1), a2 + hstep, voffA);
            PG8_WAIT_L(8); PG8_BAR; PG8_WAIT_L(0); PG8_MMA(0, 0, At, B0); PG8_BAR; PG8_SCHED;
            PG8_LDB(B1, 1, 1); PG8_STAGE(PG8_SB(1, 0), b3, voffB);
            PG8_BAR; PG8_WAIT_L(0); PG8_MMA(0, 1, At, B1); PG8_BAR;
            PG8_LDA(At, 1, 1); PG8_STAGE(PG8_SA(1, 0), a3, voffA);
            PG8_BAR; PG8_WAIT_L(0); PG8_MMA(1, 0, At, B0); PG8_BAR; PG8_SCHED;
            PG8_STAGE(PG8_SB(1, 1), b3 + hstep, voffB);
            PG8_WAIT_V(6); PG8_BAR; PG8_MMA(1, 1, At, B1); PG8_BAR;
            }
        }
        if constexpr (ALIGN_EPI) { if (wr == 0) PG8_BAR; }
        if constexpr (!Epi::AFTER_DRAIN) { E(acc, cur, wr, wc, fr, fq); S.done(cur); }
        if (!has_next) break;
#pragma unroll
        for (int a = 0; a < 2; ++a)
#pragma unroll
            for (int b = 0; b < 2; ++b)
#pragma unroll
                for (int m = 0; m < 4; ++m)
#pragma unroll
                    for (int n = 0; n < 2; ++n) acc[a][b][m][n] = (f32x4){0.f, 0.f, 0.f, 0.f};
        cur = nxt; cA = nA; cB = nB; ++ui;
        if constexpr (ALIGN_EPI) { if (wr == 1) PG8_BAR; }
    }
    PG8_WAIT_V(0);
    if constexpr (!ALIGN_EPI) { if (wr == 0) PG8_BAR; }
    PG8_BAR;
    if constexpr (Epi::AFTER_DRAIN) { E.fused(acc, cur, wr, wc, fr, fq, lds, wid, lane); S.done(cur); }
#undef PG8_SA
#undef PG8_SB
#undef PG8_STAGE
#undef PG8_LDA
#undef PG8_LDB
#undef PG8_MMA
#undef PG8_WAIT_V
#undef PG8_WAIT_L
#undef PG8_BAR
#undef PG8_SCHED
}
}
#include <hip/hip_bf16.h>
#include <cmath>
namespace attn_body {
using bf16=__hip_bfloat16;
using bf16x8=__attribute__((ext_vector_type(8)))short;
using s16x4=__attribute__((ext_vector_type(4)))short;
using f32x16=__attribute__((ext_vector_type(16)))float;
using u32x4=__attribute__((ext_vector_type(4)))unsigned;
constexpr int D=64,QP=512,KP=128,OP=1024;
constexpr int NW=8,QBLK=32,QB=QBLK*NW,KVBLK=64;
constexpr int ATTN_UNIT_ROWS=QB;
__device__ __forceinline__ int crow(int r,int hi){return (r&3)+8*(r>>2)+4*hi;}
#define SBAR() __builtin_amdgcn_sched_barrier(0)
__device__ __forceinline__ void cmask(f32x16&p0,f32x16&p1,int jb,int qrel,int hi){
  const float NEG=-INFINITY; int kb=64*jb+4*hi;
  #pragma unroll
  for(int r=0;r<16;++r){int kv=kb+(r&3)+8*(r>>2); if(kv>qrel)p0[r]=NEG; if(kv+32>qrel)p1[r]=NEG;}
}

constexpr int NSLOT=3, SLOTB=8192;
constexpr int NVSLOT=4;
constexpr int LDS_K=0, LDS_V=NSLOT*SLOTB, LDS_WS=(NSLOT+NVSLOT)*SLOTB, LDS_OST=LDS_WS+NW*64*4, LDS_BYTES=LDS_OST+NW*4096;
constexpr float C2=0.125f*1.4426950408889634f;
__device__ __forceinline__ void glds16(const void*gsrc,unsigned lds_dst){unsigned keep;
  asm volatile("s_mov_b32 %0, m0\n\ts_mov_b32 m0, %2\n\ts_nop 0\n\tglobal_load_lds_dwordx4 %1, off\n\ts_mov_b32 m0, %0":"=&s"(keep):"v"(gsrc),"s"(lds_dst):"memory");}
__device__ __forceinline__ float max3f(float a,float b,float c){float r;asm("v_max3_f32 %0, %1, %2, %3":"=v"(r):"v"(a),"v"(b),"v"(c));return r;}
__device__ __forceinline__ float max2f(float a,float b){float r;asm("v_max_f32_e32 %0, %1, %2":"=v"(r):"v"(a),"v"(b));return r;}
__device__ __forceinline__ float fadd_s(float a,float b){float r;asm("v_add_f32_e32 %0, %1, %2":"=v"(r):"v"(a),"v"(b));return r;}
__device__ __forceinline__ float fsub_s(float a,float b){float r;asm("v_sub_f32_e32 %0, %1, %2":"=v"(r):"v"(a),"v"(b));return r;}
typedef float f32x2_t __attribute__((ext_vector_type(2))); typedef __bf16 bf16x2_t __attribute__((ext_vector_type(2)));
__device__ __forceinline__ unsigned cvtpk_s(float lo,float hi){f32x2_t v={lo,hi};bf16x2_t b=__builtin_convertvector(v,bf16x2_t);return __builtin_bit_cast(unsigned,b);}
#define WAIT_BAR(N) asm volatile("s_waitcnt vmcnt(" #N ") lgkmcnt(0)\n\ts_barrier":::"memory")

__device__ __forceinline__ void qkt(f32x16&p0,f32x16&p1,const char*Kslot,const bf16x8*qr,const f32x16&negm,int r32,int hi){
  const char*kb=Kslot+hi*1024+r32*16;
  #pragma unroll
  for(int d0=0;d0<4;++d0){
    const bf16x8 b0=*reinterpret_cast<const bf16x8*>(kb+d0*2048);
    const bf16x8 b1=*reinterpret_cast<const bf16x8*>(kb+d0*2048+512);
    if(d0==0){p0=__builtin_amdgcn_mfma_f32_32x32x16_bf16(b0,qr[0],negm,0,0,0);p1=__builtin_amdgcn_mfma_f32_32x32x16_bf16(b1,qr[0],negm,0,0,0);}
    else{p0=__builtin_amdgcn_mfma_f32_32x32x16_bf16(b0,qr[d0],p0,0,0,0);p1=__builtin_amdgcn_mfma_f32_32x32x16_bf16(b1,qr[d0],p1,0,0,0);}}
}
typedef __attribute__((address_space(3))) const char* lds_cptr;
typedef short v4i16_t __attribute__((ext_vector_type(4)));
__device__ __forceinline__ void kload8(bf16x8*kf,lds_cptr kp){
  kf[0]=*(const __attribute__((address_space(3))) bf16x8*)(kp);      kf[1]=*(const __attribute__((address_space(3))) bf16x8*)(kp+512);
  kf[2]=*(const __attribute__((address_space(3))) bf16x8*)(kp+2048); kf[3]=*(const __attribute__((address_space(3))) bf16x8*)(kp+2560);
  kf[4]=*(const __attribute__((address_space(3))) bf16x8*)(kp+4096); kf[5]=*(const __attribute__((address_space(3))) bf16x8*)(kp+4608);
  kf[6]=*(const __attribute__((address_space(3))) bf16x8*)(kp+6144); kf[7]=*(const __attribute__((address_space(3))) bf16x8*)(kp+6656);
}
__device__ __forceinline__ void kload2(bf16x8*kf,lds_cptr kp,int j){ kf[2*j]=*(const __attribute__((address_space(3))) bf16x8*)(kp+j*2048); kf[2*j+1]=*(const __attribute__((address_space(3))) bf16x8*)(kp+j*2048+512); }
__device__ __forceinline__ s16x4 vtr(lds_cptr p){ return __builtin_bit_cast(s16x4,__builtin_amdgcn_ds_read_tr16_b64_v4i16((__attribute__((address_space(3))) v4i16_t*)p)); }
__device__ __forceinline__ float rowmax(const f32x16&p0,const f32x16&p1){
  float a=max3f(p0[0],p0[1],p1[0]),b=max3f(p0[2],p0[3],p1[1]);a=max3f(a,p1[2],p1[3]);
  #pragma unroll
  for(int r=4;r<16;r+=4){a=max3f(a,p0[r],p0[r+1]);b=max3f(b,p0[r+2],p0[r+3]);a=max3f(a,p1[r],p1[r+1]);b=max3f(b,p1[r+2],p1[r+3]);}
  const float m=max2f(a,b);
  auto rr=__builtin_amdgcn_permlane32_swap(__float_as_uint(m),__float_as_uint(m),false,false);
  return max2f(__uint_as_float(rr[0]),__uint_as_float(rr[1]));
}
__device__ __forceinline__ void pv(f32x16*o,int vb,bf16x8 pa0,bf16x8 pa1,bf16x8 pa2,bf16x8 pa3){
  #pragma unroll
  for(int d0=0;d0<2;++d0){s16x4 lo[4],hi[4];
    #pragma unroll
    for(int ks=0;ks<4;++ks){
      asm volatile("ds_read_b64_tr_b16 %0,%1 offset:%c2":"=&v"(lo[ks]):"v"(vb),"i"(d0*4096+ks*1024):"memory");
      asm volatile("ds_read_b64_tr_b16 %0,%1 offset:%c2":"=&v"(hi[ks]):"v"(vb),"i"(d0*4096+ks*1024+512):"memory");}
    asm volatile("s_waitcnt lgkmcnt(0)":::"memory");SBAR();
    #define PK(k) (bf16x8){lo[k][0],lo[k][1],lo[k][2],lo[k][3],hi[k][0],hi[k][1],hi[k][2],hi[k][3]}
    o[d0]=__builtin_amdgcn_mfma_f32_32x32x16_bf16(pa0,PK(0),o[d0],0,0,0);
    o[d0]=__builtin_amdgcn_mfma_f32_32x32x16_bf16(pa1,PK(1),o[d0],0,0,0);
    o[d0]=__builtin_amdgcn_mfma_f32_32x32x16_bf16(pa2,PK(2),o[d0],0,0,0);
    o[d0]=__builtin_amdgcn_mfma_f32_32x32x16_bf16(pa3,PK(3),o[d0],0,0,0);
    #undef PK
  }
}

#ifndef ATTN_STORE16
#define ATTN_STORE16(p,v) (*(u32x4*)(p)=(v))
#endif
template<int THRL> __device__ __forceinline__ void attn_unit(const bf16*Q0,const bf16*__restrict__ Kh,const bf16*__restrict__ Vh,bf16*O0,const int NT,char*shm,const int split,float*part,const float*partner,unsigned*cnt,const int ncomp){
  int tid_=threadIdx.x; asm volatile("":"+v"(tid_));
  const int tid=tid_,lane=tid&63,r32=lane&31,hi=lane>>5; const int wid=__builtin_amdgcn_readfirstlane(tid>>6);
  const bf16*Qw=Q0+(long)(wid*QBLK)*QP;
  const unsigned lds0=(unsigned)(uintptr_t)shm;
  float*wsf=(float*)(shm+LDS_WS)+wid*64;
  const bf16*ksrc=Kh+(long)lane*KP+wid*8;
  const bf16*vsrc=Vh+(long)(16*(wid&3)+(lane>>2))*KP+(wid>>2)*32+(lane&3)*8;
  const unsigned kdst=lds0+LDS_K+wid*1024, vdst=lds0+LDS_V+wid*1024;
  #define DMA_K(t,slot) glds16(ksrc+(long)(t)*KVBLK*KP,(unsigned)__builtin_amdgcn_readfirstlane(kdst+(slot)))
  #define DMA_V(t,slot) glds16(vsrc+(long)(t)*KVBLK*KP,(unsigned)__builtin_amdgcn_readfirstlane(vdst+(slot)))
  const int vb0=(int)(lds0+LDS_V)+((lane>>4)&1)*32+(lane&3)*8+(4*hi+((lane&15)>>2))*64;
  const char*Kbase=shm+LDS_K; bf16x8 kf[8];
  const lds_cptr shm3=(lds_cptr)shm; const lds_cptr kp0=shm3+LDS_K+hi*1024+r32*16; const lds_cptr vp0=shm3+LDS_V+((lane>>4)&1)*32+(lane&3)*8+(4*hi+((lane&15)>>2))*64;
  const bool stream=(ncomp==4);
  if(stream&&wid>=4){
    const int p0=2*(wid-4);
    const bf16*ks0=Kh+(long)lane*KP+p0*8, *ks1=ks0+8;
    const bf16*vs0=Vh+(long)(16*(p0&3)+(lane>>2))*KP+(p0>>2)*32+(lane&3)*8, *vs1=Vh+(long)(16*((p0+1)&3)+(lane>>2))*KP+((p0+1)>>2)*32+(lane&3)*8;
    const unsigned kd0=lds0+LDS_K+p0*1024, vd0=lds0+LDS_V+p0*1024;
    #define SK_(t) do{ const unsigned so_=(unsigned)(((t)%3)*SLOTB); glds16(ks0+(long)(t)*KVBLK*KP,(unsigned)__builtin_amdgcn_readfirstlane(kd0+so_)); glds16(ks1+(long)(t)*KVBLK*KP,(unsigned)__builtin_amdgcn_readfirstlane(kd0+1024+so_)); }while(0)
    #define SV_(t) do{ const unsigned so_=(unsigned)(((t)&3)*SLOTB); glds16(vs0+(long)(t)*KVBLK*KP,(unsigned)__builtin_amdgcn_readfirstlane(vd0+so_)); glds16(vs1+(long)(t)*KVBLK*KP,(unsigned)__builtin_amdgcn_readfirstlane(vd0+1024+so_)); }while(0)
    SK_(0);SV_(0);SK_(1);SV_(1);SK_(2);
    WAIT_BAR(8);
    WAIT_BAR(0);
    SV_(2);SK_(3);
    WAIT_BAR(4);
    for(int t=1;t+1<NT;++t){
      const bool gv=(t+2<NT),gk=(t+3<NT);
      if(gv){SV_(t+2);} if(gk){SK_(t+3);}
      if(gk){WAIT_BAR(4);} else if(gv){WAIT_BAR(2);} else {WAIT_BAR(0);}
    }
    asm volatile("s_waitcnt lgkmcnt(0)\n\ts_barrier":::"memory");
    #undef SK_
    #undef SV_
    return;
  }
  const bool dma_en=!stream;
  const int vwrap=(stream?NVSLOT-1:NSLOT-1)*SLOTB;
  if(dma_en){
  DMA_K(0,0);DMA_V(0,0);DMA_K(1,SLOTB);
  }
  bf16x8 qr[4];
  #pragma unroll
  for(int d0=0;d0<4;++d0)qr[d0]=*reinterpret_cast<const bf16x8*>(&Qw[(long)r32*QP+d0*16+hi*8]);
  float mhat=0.f,l_reg=0.f;f32x16 o[2];o[0]=f32x16{};o[1]=f32x16{};f32x16 negm=f32x16{};asm volatile("":"+v"(negm));
  #define CMASK(P0,P1,t) do{}while(0)
  bool resc=false;
  #define START(P0,P1) do{ const float rm=rowmax(P0,P1); resc=false; \
    { const float dl=rm; mhat=fadd_s(mhat,dl); \
      _Pragma("unroll") for(int r=0;r<16;++r){P0[r]=fsub_s(P0[r],dl);P1[r]=fsub_s(P1[r],dl);} \
      _Pragma("unroll") for(int r=0;r<16;++r)negm[r]=-mhat; asm volatile("":"+v"(negm)); } \
    _Pragma("unroll") for(int r=0;r<16;++r)P0[r]=__builtin_amdgcn_exp2f(P0[r]); }while(0)
  #define RESC() do{ if(resc){ asm volatile("s_waitcnt lgkmcnt(0)":::"memory"); \
      _Pragma("unroll") for(int d_=0;d_<2;++d_) _Pragma("unroll") for(int r=0;r<16;++r)o[d_][r]*=wsf[crow(r,hi)]; } }while(0)
  f32x16 pA0,pA1,pB0,pB1;
  int sl_prev=0,sl_cur=0,sl_next=SLOTB;
  int vs_prev=0,vs_cur=0,vs_next=SLOTB;
  #define ROT() do{sl_prev=sl_cur;sl_cur=sl_next;sl_next=(sl_next==(NSLOT-1)*SLOTB)?0:sl_next+SLOTB; vs_prev=vs_cur;vs_cur=vs_next;vs_next=(vs_next==vwrap)?0:vs_next+SLOTB;}while(0)
  if(dma_en){DMA_K(2,2*SLOTB);}
  WAIT_BAR(3);
  qkt(pA0,pA1,Kbase,qr,negm,r32,hi);asm volatile("s_nop 15\n\ts_nop 7":"+v"(pA0),"+v"(pA1));CMASK(pA0,pA1,0);
  START(pA0,pA1);
  _Pragma("unroll") for(int r=0;r<16;++r)pA1[r]=__builtin_amdgcn_exp2f(pA1[r]);
  WAIT_BAR(0);
  if(dma_en){DMA_K(3,0);DMA_V(1,SLOTB);}
  ROT();
  kload8(kf,kp0+sl_cur);
  WAIT_BAR(2);
  s16x4 vlo[8],vhi[8]; u32x4 pw0,pw1,pw2,pw3;
  #define PKW(P,B) cvtpk_s(P[B],P[B+1])
  #define PAF(k) __builtin_bit_cast(bf16x8,pw##k)
  #define VFR(i) (bf16x8){vlo[i][0],vlo[i][1],vlo[i][2],vlo[i][3],vhi[i][0],vhi[i][1],vhi[i][2],vhi[i][3]}
  #define PIN(x) asm volatile("":"+v"(x))
  #define MX3(a,b,c) __builtin_fmaxf(__builtin_fmaxf((a),(b)),(c))
  #define GAPA(MF,A0,A1,A2,A3,W0,W1,PW) do{ MF; sacc+=A0; sacc+=A1; sacc+=A2; sacc+=A3; PIN(sacc); W0; W1; PIN(PW); SBAR(); }while(0)
  #define EX(v) __builtin_amdgcn_exp2f(v)
  #define GAPB(MF,X,B) do{ MF; X[B]=EX(X[B]); X[B+1]=EX(X[B+1]); X[B+2]=EX(X[B+2]); X[B+3]=EX(X[B+3]); PIN(X); SBAR(); }while(0)
  #define VRD(i) do{ vlo[i]=vtr(vp_+(((i)>>2)*4096+((i)&3)*1024)); vhi[i]=vtr(vp_+(((i)>>2)*4096+((i)&3)*1024+512)); }while(0)
  #define KRD(G,j) do{ if(G){ kload2(kf,kp0+sl_next,j); SBAR(); } }while(0)
  #define STEP(C0,C1,P0,P1,t,GK,GV,GL) do{ SBAR(); \
    const lds_cptr vp_=vp0+vs_prev; \
    VRD(0); SBAR(); float sacc=(P0[0]+P0[1]); \
    GAPA(C0=__builtin_amdgcn_mfma_f32_32x32x16_bf16(kf[0],qr[0],negm,0,0,0), P0[2],P0[3],P0[4],P0[5],     pw0[0]=PKW(P0,0), pw0[1]=PKW(P0,2), pw0); \
    VRD(4); SBAR(); GAPA(C1=__builtin_amdgcn_mfma_f32_32x32x16_bf16(kf[1],qr[0],negm,0,0,0), P0[6],P0[7],P0[8],P0[9],     pw0[2]=PKW(P0,4), pw0[3]=PKW(P0,6), pw0); \
    VRD(1); SBAR(); GAPA(C0=__builtin_amdgcn_mfma_f32_32x32x16_bf16(kf[2],qr[1],C0,0,0,0),   P0[10],P0[11],P0[12],P0[13], pw1[0]=PKW(P0,8), pw1[1]=PKW(P0,10), pw1); \
    VRD(5); SBAR(); GAPA(C1=__builtin_amdgcn_mfma_f32_32x32x16_bf16(kf[3],qr[1],C1,0,0,0),   P0[14],P0[15],P1[0],P1[1],   pw1[2]=PKW(P0,12),pw1[3]=PKW(P0,14), pw1); \
    VRD(2); SBAR(); GAPA(C0=__builtin_amdgcn_mfma_f32_32x32x16_bf16(kf[4],qr[2],C0,0,0,0),   P1[2],P1[3],P1[4],P1[5],     pw2[0]=PKW(P1,0), pw2[1]=PKW(P1,2), pw2); \
    VRD(6); SBAR(); GAPA(C1=__builtin_amdgcn_mfma_f32_32x32x16_bf16(kf[5],qr[2],C1,0,0,0),   P1[6],P1[7],P1[8],P1[9],     pw2[2]=PKW(P1,4), pw2[3]=PKW(P1,6), pw2); \
    VRD(3); SBAR(); GAPA(C0=__builtin_amdgcn_mfma_f32_32x32x16_bf16(kf[6],qr[3],C0,0,0,0),   P1[10],P1[11],P1[12],P1[13], pw3[0]=PKW(P1,8), pw3[1]=PKW(P1,10), pw3); \
    VRD(7); SBAR(); GAPA(C1=__builtin_amdgcn_mfma_f32_32x32x16_bf16(kf[7],qr[3],C1,0,0,0),   P1[14],P1[15],0.f,0.f,       pw3[2]=PKW(P1,12),pw3[3]=PKW(P1,14), pw3); \
    l_reg+=sacc; \
    if(dma_en){ if(GK){DMA_K((t)+3,sl_cur);} if(GV){DMA_V((t)+1,sl_next);} } \
    CMASK(C0,C1,t); \
    { float a=MX3(C0[0],C0[1],C1[0]),b=MX3(C0[2],C0[3],C1[1]); a=MX3(a,C1[2],C1[3]); \
      _Pragma("unroll") for(int r=4;r<16;r+=4){a=MX3(a,C0[r],C0[r+1]);b=MX3(b,C0[r+2],C0[r+3]);a=MX3(a,C1[r],C1[r+1]);b=MX3(b,C1[r+2],C1[r+3]);} \
      float rm=__builtin_fmaxf(a,b); { auto rr=__builtin_amdgcn_permlane32_swap(__float_as_uint(rm),__float_as_uint(rm),false,false); rm=__builtin_fmaxf(__uint_as_float(rr[0]),__uint_as_float(rr[1])); } \
      resc=false; \
      if(__builtin_expect(__any(rm>(float)THRL),0)){ const float dl=__builtin_fmaxf(rm,0.f); mhat+=dl; \
        _Pragma("unroll") for(int r=0;r<16;++r){C0[r]-=dl;C1[r]-=dl;} \
        _Pragma("unroll") for(int r=0;r<16;++r)negm[r]=-mhat; asm volatile("":"+v"(negm)); \
        const float f=__builtin_amdgcn_exp2f(-dl); l_reg*=f; if(hi==0)wsf[r32]=f; resc=true; } } \
    SBAR(); \
    GAPB(o[0]=__builtin_amdgcn_mfma_f32_32x32x16_bf16(PAF(0),VFR(0),o[0],0,0,0), C0,0); \
    GAPB(o[1]=__builtin_amdgcn_mfma_f32_32x32x16_bf16(PAF(0),VFR(4),o[1],0,0,0), C0,4); \
    KRD(GL,0); GAPB(o[0]=__builtin_amdgcn_mfma_f32_32x32x16_bf16(PAF(1),VFR(1),o[0],0,0,0), C0,8); \
    KRD(GL,1); GAPB(o[1]=__builtin_amdgcn_mfma_f32_32x32x16_bf16(PAF(1),VFR(5),o[1],0,0,0), C0,12); \
    KRD(GL,2); GAPB(o[0]=__builtin_amdgcn_mfma_f32_32x32x16_bf16(PAF(2),VFR(2),o[0],0,0,0), C1,0); \
    KRD(GL,3); GAPB(o[1]=__builtin_amdgcn_mfma_f32_32x32x16_bf16(PAF(2),VFR(6),o[1],0,0,0), C1,4); \
    GAPB(o[0]=__builtin_amdgcn_mfma_f32_32x32x16_bf16(PAF(3),VFR(3),o[0],0,0,0), C1,8); \
    GAPB(o[1]=__builtin_amdgcn_mfma_f32_32x32x16_bf16(PAF(3),VFR(7),o[1],0,0,0), C1,12); \
    }while(0)
  int t=1;
  #undef CMASK
  #define CMASK(P0,P1,t) do{}while(0)
  for(;t+5<NT;t+=2){
    STEP(pB0,pB1,pA0,pA1,t,true,true,true);     WAIT_BAR(2); RESC(); ROT();
    STEP(pA0,pA1,pB0,pB1,t+1,true,true,true);   WAIT_BAR(2); RESC(); ROT();
  }
  #undef CMASK
  #define CMASK(P0,P1,t) do{}while(0)
  #define ENDW(tt) do{ if((tt)+3<NT){WAIT_BAR(2);} else if((tt)+2<NT){WAIT_BAR(1);} else {WAIT_BAR(0);} }while(0)
  for(;t+1<NT;t+=2){
    STEP(pB0,pB1,pA0,pA1,t,(t+3<NT),(t+1<NT),(t+1<NT));       ENDW(t);   RESC(); ROT();
    STEP(pA0,pA1,pB0,pB1,t+1,(t+4<NT),(t+2<NT),(t+2<NT));     ENDW(t+1); RESC(); ROT();
  }
  STEP(pB0,pB1,pA0,pA1,NT-1,false,false,false); RESC();
  { float sacc=pB0[0]+pB0[1]; _Pragma("unroll") for(int r=2;r<16;++r)sacc+=pB0[r]; _Pragma("unroll") for(int r=0;r<16;++r)sacc+=pB1[r]; l_reg+=sacc;
    pw0=(u32x4){PKW(pB0,0),PKW(pB0,2),PKW(pB0,4),PKW(pB0,6)};pw1=(u32x4){PKW(pB0,8),PKW(pB0,10),PKW(pB0,12),PKW(pB0,14)};pw2=(u32x4){PKW(pB1,0),PKW(pB1,2),PKW(pB1,4),PKW(pB1,6)};pw3=(u32x4){PKW(pB1,8),PKW(pB1,10),PKW(pB1,12),PKW(pB1,14)};
    SBAR(); pv(o,vb0+vs_cur,PAF(0),PAF(1),PAF(2),PAF(3)); }
  #undef PKW
  #undef PAF
  #undef VFR
  #undef PIN
  #undef MX3
  #undef GAPA
  #undef GAPB
  #undef EX
  #undef VRD
  #undef KRD
  #undef STEP
  #undef ENDW
  {auto rr=__builtin_amdgcn_permlane32_swap(__float_as_uint(l_reg),__float_as_uint(l_reg),false,false);l_reg=__uint_as_float(rr[0])+__uint_as_float(rr[1]);}
  if(hi==0)wsf[32+r32]=l_reg;asm volatile("s_waitcnt lgkmcnt(0)":::"memory");
  float rli[16];
  bool writer=true;
  if(split){
    float*po=part+wid*2048; float*ps=part+8*2048+wid*64;
    #pragma unroll
    for(int d0=0;d0<2;++d0)
      #pragma unroll
      for(int r=0;r<16;++r)__hip_atomic_store(po+(d0*16+r)*64+lane,o[d0][r],__ATOMIC_RELAXED,__HIP_MEMORY_SCOPE_AGENT);
    if(hi==0){__hip_atomic_store(ps+r32,mhat,__ATOMIC_RELAXED,__HIP_MEMORY_SCOPE_AGENT);__hip_atomic_store(ps+32+r32,l_reg,__ATOMIC_RELAXED,__HIP_MEMORY_SCOPE_AGENT);}
    asm volatile("s_waitcnt vmcnt(0)":::"memory");
    unsigned old_=0u; if(lane==0)old_=__hip_atomic_fetch_add(cnt+wid,1u,__ATOMIC_RELAXED,__HIP_MEMORY_SCOPE_AGENT);
    old_=(unsigned)__builtin_amdgcn_readfirstlane((int)old_);
    writer=(old_!=0u);
    if(writer){
      __builtin_amdgcn_fence(__ATOMIC_ACQUIRE,"agent");
      const float*qo=partner+wid*2048; const float*qs=partner+8*2048+wid*64;
      const float mp=__hip_atomic_load(qs+r32,__ATOMIC_RELAXED,__HIP_MEMORY_SCOPE_AGENT),lp=__hip_atomic_load(qs+32+r32,__ATOMIC_RELAXED,__HIP_MEMORY_SCOPE_AGENT);
      const float Mx=__builtin_fmaxf(mhat,mp),fo=__builtin_amdgcn_exp2f(mhat-Mx),fp=__builtin_amdgcn_exp2f(mp-Mx);
      const float inv=__builtin_amdgcn_rcpf(l_reg*fo+lp*fp);
      if(hi==0){wsf[32+r32]=fo*inv;wsf[r32]=fp*inv;} asm volatile("s_waitcnt lgkmcnt(0)":::"memory");
      #pragma unroll
      for(int r=0;r<16;++r){const float so=wsf[32+crow(r,hi)],sp=wsf[crow(r,hi)];
        #pragma unroll
        for(int d0=0;d0<2;++d0)o[d0][r]=o[d0][r]*so+__hip_atomic_load(qo+(d0*16+r)*64+lane,__ATOMIC_RELAXED,__HIP_MEMORY_SCOPE_AGENT)*sp;
        rli[r]=1.f;}
    }
  } else {
  #pragma unroll
  for(int r=0;r<16;++r)rli[r]=__builtin_amdgcn_rcpf(wsf[32+crow(r,hi)]);
  }
  bf16*Ow=O0+(long)(wid*QBLK)*OP;
  if(writer){ bf16*stg=(bf16*)(shm+LDS_OST)+wid*2048;
    #pragma unroll
    for(int r=0;r<16;++r){const int orow=crow(r,hi);
      #pragma unroll
      for(int d0=0;d0<2;++d0)stg[orow*64+d0*32+r32]=__float2bfloat16(o[d0][r]*rli[r]);}
    asm volatile("s_waitcnt lgkmcnt(0)":::"memory");
    #pragma unroll
    for(int i=0;i<4;++i){const int row=i*8+(lane>>3),ch=lane&7; const u32x4 v=*(const u32x4*)(stg+row*64+ch*8); ATTN_STORE16(Ow+(long)row*OP+ch*8,v);} }
  asm volatile("s_waitcnt lgkmcnt(0)\n\ts_barrier":::"memory");
  #undef DMA_K
  #undef DMA_V
  #undef CMASK
  #undef START
  #undef RESC
  #undef ROT
}
constexpr int ATTN_LDS_BYTES=LDS_BYTES;
#undef SBAR
#undef WAIT_BAR
}
#define GAS __attribute__((address_space(1)))
#define LAS __attribute__((address_space(3)))
typedef unsigned short bf16;
typedef unsigned v4u __attribute__((ext_vector_type(4)));
typedef unsigned v2u __attribute__((ext_vector_type(2)));
typedef float f32x4 __attribute__((ext_vector_type(4)));
#define LDS_WAIT() asm volatile("s_waitcnt lgkmcnt(0)" ::: "memory")
__device__ __forceinline__ unsigned f2bf(float f) { unsigned u = __builtin_bit_cast(unsigned, f); return (u + 0x7fffu + ((u >> 16) & 1u)) >> 16; }
__device__ __forceinline__ unsigned pk2(float lo, float hi) { return pg8::cvt_pk_bf16(lo, hi); }
__device__ __forceinline__ float bf_lo(unsigned w) { return __builtin_bit_cast(float, w << 16); }
__device__ __forceinline__ float bf_hi(unsigned w) { return __builtin_bit_cast(float, w & 0xffff0000u); }
typedef _Float16 h16x2 __attribute__((ext_vector_type(2)));
__device__ __forceinline__ unsigned pkh2(float lo, float hi) { h16x2 v = {(_Float16)lo, (_Float16)hi}; return __builtin_bit_cast(unsigned, v); }
__device__ __forceinline__ float h_lo(unsigned w) { return (float)__builtin_bit_cast(h16x2, w).x; }
__device__ __forceinline__ float h_hi(unsigned w) { return (float)__builtin_bit_cast(h16x2, w).y; }

constexpr int D = 1024, NCTX = 8192, NLAT = 4096, M = NCTX + NLAT, DEPTH = 4, SEQ = 256, LSEQ = 2048, PAST = 512, LKEYS = PAST + LSEQ;
constexpr int NIN = 1280, DFF = 2816, NUP = 2 * DFF, NMOD = 6 * D;
constexpr float EPS = 1e-6f;
constexpr int NWAVES = 8, NTHR = 512;
constexpr size_t MiB = 1u << 20;
constexpr size_t WS_ZERO_BYTES = 2 * MiB;
constexpr size_t WS_MOD = 1 * MiB;
constexpr size_t WS_ACNT = 64 * 1024;
constexpr int APART_FLOATS = 8 * 2048 + 8 * 64;
constexpr size_t WS_APART = 222 * MiB;
constexpr size_t WS_RS = 262 * MiB;
constexpr size_t WS_GM = 12 * MiB + 512 * 1024;
constexpr size_t WS_B1 = 12 * MiB + 768 * 1024;
constexpr size_t WS_B5 = 13 * MiB;
constexpr size_t WS_WIN = 2 * MiB;
constexpr size_t WS_WOUT = 14 * MiB;
constexpr size_t WS_WUP = 22 * MiB;
constexpr size_t WS_WDN = 66 * MiB;
constexpr size_t WS_X = 88 * MiB;
constexpr size_t WS_H = 354 * MiB;
constexpr size_t WS_Q = 160 * MiB;
constexpr size_t WS_U = 172 * MiB;
constexpr size_t WS_AO = 184 * MiB;
constexpr size_t WS_ACT = 136 * MiB;
constexpr size_t WS_KC = 208 * MiB, WS_VC = 210 * MiB;
constexpr size_t WS_KL = 212 * MiB, WS_VL = 217 * MiB;
constexpr size_t WS_HALO = 222 * MiB + 32 * MiB;
constexpr size_t WS_Z = 222 * MiB;
constexpr size_t WS_END = 378 * MiB;
static_assert(WS_ACT + (size_t)M * DFF * 2 <= WS_KC, "ACT overlay");
constexpr int LDS_BYTES = 147456;

struct Args { const float* in[21]; float* out; unsigned char* ws; int ph_lo, ph_hi; };
enum { I_XP = 0, I_XS, I_CK, I_CV, I_C, I_CCTX, I_WMOD, I_BMOD, I_N1G, I_WIN, I_QG, I_KG, I_WPOOL, I_PSC, I_WOUT, I_N2G, I_WUP, I_CW, I_CB, I_WDN, I_FNG };

__device__ __forceinline__ float xadd16(float v) { auto r = __builtin_amdgcn_permlane16_swap(__float_as_uint(v), __float_as_uint(v), false, false); return __uint_as_float(r[0]) + __uint_as_float(r[1]); }
__device__ __forceinline__ float xadd32(float v) { auto r = __builtin_amdgcn_permlane32_swap(__float_as_uint(v), __float_as_uint(v), false, false); return __uint_as_float(r[0]) + __uint_as_float(r[1]); }
template <int CTRL> __device__ __forceinline__ float dpp_f(float v) { return __int_as_float(__builtin_amdgcn_update_dpp(0, __float_as_int(v), CTRL, 0xf, 0xf, false)); }
__device__ __forceinline__ float wave_sum(float v) {
    v += dpp_f<0xB1>(v);
    v += dpp_f<0x4E>(v);
    v += dpp_f<0x124>(v);
    v += dpp_f<0x128>(v);
    return xadd32(xadd16(v));
}
__device__ __forceinline__ const float* ain(const Args& a, int i) { asm volatile("" : "+s"(i)); return a.in[i]; }
__device__ __forceinline__ int row_cond(int row) { return row < NCTX ? 0 : 1 + ((row - NCTX) >> 11); }

struct TrItem { const float* src; bf16* dst; int ldw, ldt; };
__device__ __forceinline__ void tr_load(const TrItem& t, float (&r)[32], int lane) {
#pragma unroll
    for (int i = 0; i < 8; ++i) { const f32x4 v = *(const f32x4*)(t.src + (size_t)(8 * i + (lane >> 3)) * t.ldw + (lane & 7) * 4);
        r[4 * i] = v.x; r[4 * i + 1] = v.y; r[4 * i + 2] = v.z; r[4 * i + 3] = v.w; }
}
__device__ __forceinline__ void tr_store(const TrItem& t, const float (&r)[32], LAS float* scr, int lane) {
#pragma unroll
    for (int i = 0; i < 8; ++i) { LAS float* p = scr + (8 * i + (lane >> 3)) * 33 + (lane & 7) * 4;
        p[0] = r[4 * i]; p[1] = r[4 * i + 1]; p[2] = r[4 * i + 2]; p[3] = r[4 * i + 3]; }
    LDS_WAIT(); asm volatile("" ::: "memory");
    const int c = lane & 7;
#pragma unroll
    for (int j = 0; j < 4; ++j) { const int n = (lane >> 3) + 8 * j; const LAS float* s = scr + (8 * c) * 33 + n;
        v4u o; o.x = pk2(s[0 * 33], s[1 * 33]); o.y = pk2(s[2 * 33], s[3 * 33]); o.z = pk2(s[4 * 33], s[5 * 33]); o.w = pk2(s[6 * 33], s[7 * 33]);
        *(v4u*)(t.dst + (size_t)n * t.ldt + 8 * c) = o; }
    LDS_WAIT(); asm volatile("" ::: "memory");
}
__device__ __forceinline__ float silu_f(float x) { return x / (1.f + __expf(-x)); }

__device__ __forceinline__ void weff_layer(const Args& a, unsigned char* ws, LAS unsigned char* lds, int gw, int NGW, int lane, int wave, int l) {
    {
        LAS float* wps = (LAS float*)(lds + wave * 12288);
        for (int it = gw; it < 4 * 8 * 16; it += NGW) {
            const int nb = it & 15, ib = (it >> 4) & 7, g = (it >> 7) & 3;
            const float* wp = ain(a, I_WPOOL) + ((size_t)(l * 4 + g) * 128 + ib * 16) * 128;
            const float* ps = ain(a, I_PSC) + l * 512 + g * 128;
            const float* wo = ain(a, I_WOUT) + ((size_t)l * D + 512 + g * 128) * D + nb * 64 + lane;
            { const int ii = lane >> 2, js = (lane & 3) * 32;
#pragma unroll
                for (int q = 0; q < 8; ++q) { const f32x4 w = *(const f32x4*)(wp + ii * 128 + js + 4 * q) * *(const f32x4*)(ps + js + 4 * q);
                    wps[(js + 4 * q + 0) * 16 + ii] = w.x; wps[(js + 4 * q + 1) * 16 + ii] = w.y; wps[(js + 4 * q + 2) * 16 + ii] = w.z; wps[(js + 4 * q + 3) * 16 + ii] = w.w; } }
            LDS_WAIT(); asm volatile("" ::: "memory");
            f32x4 acc[4];
#pragma unroll
            for (int i = 0; i < 4; ++i) acc[i] = (f32x4){0.f, 0.f, 0.f, 0.f};
#pragma unroll 32
            for (int j = 0; j < 128; ++j) { const float wv = wo[(size_t)j * D];
#pragma unroll
                for (int i = 0; i < 4; ++i) acc[i] += *(const LAS f32x4*)(wps + j * 16 + 4 * i) * wv; }
            bf16* dst = (bf16*)(ws + WS_WOUT) + ((size_t)l * D + nb * 64 + lane) * D + 512 + g * 128 + ib * 16;
            v4u o0, o1; o0.x = pk2(acc[0].x, acc[0].y); o0.y = pk2(acc[0].z, acc[0].w); o0.z = pk2(acc[1].x, acc[1].y); o0.w = pk2(acc[1].z, acc[1].w);
            o1.x = pk2(acc[2].x, acc[2].y); o1.y = pk2(acc[2].z, acc[2].w); o1.z = pk2(acc[3].x, acc[3].y); o1.w = pk2(acc[3].z, acc[3].w);
            *(v4u*)dst = o0; *(v4u*)(dst + 8) = o1;
            LDS_WAIT(); asm volatile("" ::: "memory");
        }
    }
}
__device__ __forceinline__ void convert_layer(const Args& a, unsigned char* ws, LAS unsigned char* lds, int gw, int NGW, int lane, int wave, int l, int part) {
    {
        LAS float* scr = (LAS float*)(lds + wave * 12288);
        constexpr int I_IN = 16 * 40, I_OUT = 8 * 32, I_UP = 16 * 176, I_DN = 44 * 32, I_L = I_IN + I_OUT + I_UP + I_DN;
        auto decode = [&](int it) -> TrItem {
            int r = it; TrItem t;
            if (r < I_IN) { const int kb = r / 40, nb = r % 40, n0 = nb * 32, pn = n0 >> 8, lc = n0 & 255, wc = lc >> 6, bj = (lc >> 5) & 1;
                t.src = ain(a, I_WIN) + (size_t)l * D * NIN + (size_t)(kb * 64) * NIN + n0; t.ldw = NIN;
                t.dst = (bf16*)(ws + WS_WIN) + (size_t)l * NIN * D + (size_t)(pn * 256 + bj * 128 + wc * 32) * D + kb * 64; t.ldt = D; return t; }
            r -= I_IN;
            if (r < I_OUT) { const int kb = r / 32, nb = r % 32;
                t.src = ain(a, I_WOUT) + (size_t)l * D * D + (size_t)(kb * 64) * D + nb * 32; t.ldw = D;
                t.dst = (bf16*)(ws + WS_WOUT) + (size_t)l * D * D + (size_t)(nb * 32) * D + kb * 64; t.ldt = D; return t; }
            r -= I_OUT;
            if (r < I_UP) { const int kb = r / 176, nb = r % 176, n0 = nb * 32, hf = n0 >= DFF, chn = n0 - hf * DFF;
                t.src = ain(a, I_WUP) + (size_t)l * D * NUP + (size_t)(kb * 64) * NUP + n0; t.ldw = NUP;
                t.dst = (bf16*)(ws + WS_WUP) + (size_t)l * NUP * D + (size_t)((chn >> 7) * 256 + hf * 128 + (chn & 127)) * D + kb * 64; t.ldt = D; return t; }
            r -= I_UP;
            { const int kb = r / 32, nb = r % 32;
                t.src = ain(a, I_WDN) + (size_t)l * DFF * D + (size_t)(kb * 64) * D + nb * 32; t.ldw = D;
                t.dst = (bf16*)(ws + WS_WDN) + (size_t)l * D * DFF + (size_t)(nb * 32) * DFF + kb * 64; t.ldt = DFF; return t; }
        };
        const int it0 = (part == 1 ? I_IN + I_OUT : 0) + gw, NIT = (part == 0 ? I_IN + I_OUT : I_L);
        if (it0 < NIT) {
            TrItem cur = decode(it0); float rc[32]; tr_load(cur, rc, lane);
            for (int it = it0; it < NIT; it += NGW) {
                const bool has = it + NGW < NIT; TrItem nxt = cur; float rn[32];
                if (has) { nxt = decode(it + NGW); tr_load(nxt, rn, lane); }
                tr_store(cur, rc, scr, lane);
                if (has) { cur = nxt;
#pragma unroll
                    for (int i = 0; i < 32; ++i) rc[i] = rn[i]; }
            }
        }
    }
}
__device__ __forceinline__ void prologue(const Args& a, LAS unsigned char* lds, int vcu, int G, int tid, int lane, int wave, int nl_pre) {
    size_t wz_ = 0; asm volatile("" : "+s"(wz_)); unsigned char* ws = a.ws + wz_;
    const int gw = vcu * NWAVES + wave, NGW = G * NWAVES;
    {
        typedef float f32x2_ __attribute__((ext_vector_type(2)));
        LAS f32x2_* red = (LAS f32x2_*)lds;
        const float* cc = ain(a, I_CCTX); const float* c1 = ain(a, I_C);
        for (int it = vcu; it < DEPTH * 48; it += G) {
            const int l = it / 48, cb = it % 48;
            const float* W = ain(a, I_WMOD) + (size_t)l * D * NMOD + cb * 128 + lane * 2;
            f32x2_ a0 = {0.f, 0.f}, a1 = a0, a2 = a0;
            const int kb = wave * 128;
#pragma unroll 32
            for (int k = 0; k < 128; ++k) {
                const f32x2_ w = *(const f32x2_*)(W + (size_t)(kb + k) * NMOD);
                const float s0 = silu_f(cc[kb + k]), s1 = silu_f(c1[kb + k]), s2 = silu_f(c1[D + kb + k]);
                a0 += w * s0; a1 += w * s1; a2 += w * s2;
            }
            red[(wave * 3 + 0) * 64 + lane] = a0; red[(wave * 3 + 1) * 64 + lane] = a1; red[(wave * 3 + 2) * 64 + lane] = a2;
            __syncthreads();
            if (tid < 192) { const int cnd = tid >> 6; f32x2_ s = *(const f32x2_*)(ain(a, I_BMOD) + (size_t)l * NMOD + cb * 128 + lane * 2);
#pragma unroll
                for (int w = 0; w < 8; ++w) s += red[(w * 3 + cnd) * 64 + lane];
                *(f32x2_*)((float*)(ws + WS_MOD) + ((size_t)l * 3 + cnd) * NMOD + cb * 128 + lane * 2) = s; }
            __syncthreads();
        }
    }
#ifdef PROBE_PRO2
    for (int rep_ = 0; rep_ < 2; ++rep_) {
#endif
    for (int it = gw * 64 + lane; it < 2 * DEPTH * PAST * 16 * 2; it += NGW * 64) {
        const int which = it & 1, r = it >> 1, c8 = r & 15, p = (r >> 4) & 511, l = (r >> 13) & 3, b = r >> 15;
        const float* src = a.in[which ? I_CV : I_CK] + (((size_t)(b * DEPTH + l) * PAST + p) * 128 + c8 * 8);
        const f32x4 x0 = *(const f32x4*)src, x1 = *(const f32x4*)(src + 4);
        v4u o; o.x = pk2(x0.x, x0.y); o.y = pk2(x0.z, x0.w); o.z = pk2(x1.x, x1.y); o.w = pk2(x1.z, x1.w);
        *(v4u*)((bf16*)(ws + (which ? WS_VL : WS_KL)) + (((size_t)(l * 2 + b) * LKEYS + p) * 128 + c8 * 8)) = o;
    }
    for (int l = 0; l < nl_pre; ++l) { weff_layer(a, ws, lds, gw, NGW, lane, wave, l); convert_layer(a, ws, lds, gw, NGW, lane, wave, l, 2); }
#ifdef PROBE_PRO2
    }
#endif
}

__device__ __forceinline__ void bias_rows(unsigned char* ws, int gw, int NGW, int lane, int l, bool up) {
    const float* mod = (const float*)(ws + WS_MOD);
    for (int n = gw; n < (up ? NUP : NIN); n += NGW) {
        const bf16* wrow = up ? (const bf16*)(ws + WS_WUP) + ((size_t)l * NUP + n) * D : (const bf16*)(ws + WS_WIN) + ((size_t)l * NIN + n) * D;
        const v4u w0 = *(const v4u*)(wrow + lane * 16), w1 = *(const v4u*)(wrow + lane * 16 + 8);
        float wf[16] = {bf_lo(w0.x), bf_hi(w0.x), bf_lo(w0.y), bf_hi(w0.y), bf_lo(w0.z), bf_hi(w0.z), bf_lo(w0.w), bf_hi(w0.w),
                        bf_lo(w1.x), bf_hi(w1.x), bf_lo(w1.y), bf_hi(w1.y), bf_lo(w1.z), bf_hi(w1.z), bf_lo(w1.w), bf_hi(w1.w)};
        float s[3];
#pragma unroll
        for (int c = 0; c < 3; ++c) { const float* sh = mod + ((size_t)l * 3 + c) * NMOD + (up ? 3 * D : 0) + lane * 16; float acc = 0.f;
#pragma unroll
            for (int q = 0; q < 4; ++q) { const f32x4 x = *(const f32x4*)(sh + 4 * q); acc += (x.x * wf[4 * q] + x.y * wf[4 * q + 1]) + (x.z * wf[4 * q + 2] + x.w * wf[4 * q + 3]); }
            s[c] = wave_sum(acc); }
        if (lane == 0) { float* o = up ? (float*)(ws + WS_B5) + (size_t)l * 3 * NUP + n : (float*)(ws + WS_B1) + (size_t)l * 3 * NIN + n; const int st = up ? NUP : NIN;
            o[0] = s[0]; o[st] = s[1]; o[2 * st] = s[2]; }
    }
}
__device__ __forceinline__ void phase1(const Args& a, int gw, int NGW, int lane, int nl_pre) {
    size_t wz_ = 0; asm volatile("" : "+s"(wz_)); unsigned char* ws = a.ws + wz_;
    const float* mod = (const float*)(ws + WS_MOD);
    for (int it = gw * 64 + lane; it < DEPTH * 2 * 3 * D; it += NGW * 64) {
        const int col = it & 1023, cnd = (it >> 10) % 3, w = ((it >> 10) / 3) & 1, l = (it >> 10) / 6;
        const float g = (w ? ain(a, I_N2G) : ain(a, I_N1G))[l * D + col];
        ((float*)(ws + WS_GM))[it] = g * (1.f + mod[((size_t)l * 3 + cnd) * NMOD + (w ? 4 * D : D) + col]);
    }
    for (int l = 0; l < nl_pre; ++l) { bias_rows(ws, gw, NGW, lane, l, false); bias_rows(ws, gw, NGW, lane, l, true); }
    bf16* X = (bf16*)(ws + WS_X);
    f32x4 g[4];
#pragma unroll
    for (int j = 0; j < 4; ++j) g[j] = *(const f32x4*)(ain(a, I_N1G) + 256 * j + lane * 4);
    for (int row = gw; row < M; row += NGW) {
        const float* src = row < NCTX ? ain(a, I_XP) + (size_t)row * D : ain(a, I_XS) + (size_t)(row - NCTX) * D;
        const float* sc = mod + (size_t)row_cond(row) * NMOD + D;
        bf16* h = (bf16*)(ws + WS_H) + (size_t)row * D;
        float s = 0.f;
#pragma unroll
        for (int j = 0; j < 4; ++j) { const f32x4 v = *(const f32x4*)(src + 256 * j + lane * 4); s += (v.x * v.x + v.y * v.y) + (v.z * v.z + v.w * v.w);
            const f32x4 y = v * g[j] * (*(const f32x4*)(sc + 256 * j + lane * 4) + 1.f);
            v2u o; o.x = pk2(y.x, y.y); o.y = pk2(y.z, y.w); *(v2u*)(h + 256 * j + lane * 4) = o;
            v2u xo_; xo_.x = pkh2(v.x, v.y); xo_.y = pkh2(v.z, v.w); *(v2u*)(X + (size_t)row * D + 256 * j + lane * 4) = xo_; }
        s = wave_sum(s);
        if (lane == 0) *(f32x4*)((float*)(ws + WS_RS) + (size_t)row * 4) = (f32x4){s, 0.f, 0.f, 0.f};
    }
}
__device__ __forceinline__ void final_norm(const Args& a, int gw, int NGW, int lane) {
    size_t wz_ = 0; asm volatile("" : "+s"(wz_)); unsigned char* ws = a.ws + wz_;     const bf16* X = (const bf16*)(ws + WS_X);
    f32x4 g[4];
#pragma unroll
    for (int j = 0; j < 4; ++j) g[j] = *(const f32x4*)(ain(a, I_FNG) + 256 * j + lane * 4);
    for (int row = gw; row < M; row += 2 * NGW) {
        const int row2 = row + NGW; const bool has2 = row2 < M;
        f32x4 v[4], w[4]; float s = 0.f, s2 = 0.f;
#pragma unroll
        for (int j = 0; j < 4; ++j) { const v2u a_ = *(const v2u*)(X + (size_t)row * D + 256 * j + lane * 4); v2u b_ = {0u, 0u}; if (has2) b_ = *(const v2u*)(X + (size_t)row2 * D + 256 * j + lane * 4);
            v[j] = (f32x4){h_lo(a_.x), h_hi(a_.x), h_lo(a_.y), h_hi(a_.y)}; w[j] = (f32x4){h_lo(b_.x), h_hi(b_.x), h_lo(b_.y), h_hi(b_.y)}; }
#pragma unroll
        for (int j = 0; j < 4; ++j) { s += (v[j].x * v[j].x + v[j].y * v[j].y) + (v[j].z * v[j].z + v[j].w * v[j].w); s2 += (w[j].x * w[j].x + w[j].y * w[j].y) + (w[j].z * w[j].z + w[j].w * w[j].w); }
        const float rstd = 1.f / sqrtf(wave_sum(s) * (1.f / D) + EPS), rstd2 = 1.f / sqrtf(wave_sum(s2) * (1.f / D) + EPS);
#pragma unroll
        for (int j = 0; j < 4; ++j) { *(f32x4*)(a.out + (size_t)row * D + 256 * j + lane * 4) = v[j] * rstd * g[j]; if (has2) *(f32x4*)(a.out + (size_t)row2 * D + 256 * j + lane * 4) = w[j] * rstd2 * g[j]; }
    }
}

#ifndef QKV_NOROPE
#define QKV_NOROPE
#endif
namespace pg8 {
__device__ __forceinline__ void rope2(float& x1, float& x2, float rev) { rev = rev - floorf(rev); const float sn = __builtin_amdgcn_sinf(rev), cs = __builtin_amdgcn_cosf(rev); const float a = x1 * cs - x2 * sn, b = x1 * sn + x2 * cs; x1 = a; x2 = b; }
template <int KIND> __device__ __forceinline__ void qkv_rows(const f32x4 (&acc)[2][2][4][2], bf16_t* dst0, int pitch, float* c0, const float* gp, bool lat, int t0, int fq, const float* rs0, const float* bp) {
    float rstd_in[2][4];
#pragma unroll
    for (int ai = 0; ai < 2; ++ai) {
#pragma unroll
        for (int m = 0; m < 4; ++m) { const f32x4 p_ = *(const f32x4*)(rs0 + (ai * HALF + m * 16) * 4); rstd_in[ai][m] = __builtin_amdgcn_rsqf(((p_.x + p_.y) + (p_.z + p_.w)) * (1.f / 1024.f) + 1e-6f); }
        asm volatile("" : "+v"(rstd_in[ai][0]), "+v"(rstd_in[ai][1]), "+v"(rstd_in[ai][2]), "+v"(rstd_in[ai][3]) :: "memory");
    }
    const f32x4 b00 = *(const f32x4*)(bp), b01 = *(const f32x4*)(bp + 16), b10 = *(const f32x4*)(bp + 128), b11 = *(const f32x4*)(bp + 144);
    f32x4 g00 = {1.f, 1.f, 1.f, 1.f}, g01 = g00, g10 = g00, g11 = g00;
    if (KIND < 2) { g00 = *(const f32x4*)(gp); g01 = *(const f32x4*)(gp + 16); g10 = *(const f32x4*)(gp + 32); g11 = *(const f32x4*)(gp + 48); }
    float i0 = 0.f, i1 = 0.f, i2 = 0.f, i3 = 0.f;
    if (KIND < 2) { const float k = -(13.287712379549449f / 16.0f), r2pi = 0.15915494309189535f;
        i0 = __builtin_amdgcn_exp2f((float)(4 * fq + 0) * k) * r2pi; i1 = __builtin_amdgcn_exp2f((float)(4 * fq + 1) * k) * r2pi;
        i2 = __builtin_amdgcn_exp2f((float)(4 * fq + 2) * k) * r2pi; i3 = __builtin_amdgcn_exp2f((float)(4 * fq + 3) * k) * r2pi; }
    const float qscale = KIND == 0 ? 0.125f * 1.4426950408889634f : 1.f;
#pragma unroll
    for (int ai = 0; ai < 2; ++ai)
#pragma unroll
        for (int m = 0; m < 4; ++m) {
            const int dr = ai * HALF + m * 16;
            bf16_t* dst = dst0; float* co = c0; asm volatile("" : "+v"(dst), "+v"(co));
            GAS bf16_t* dstg = (GAS bf16_t*)dst + dr * pitch; GAS float* cog = (GAS float*)co + dr * 128;
            const float ri = rstd_in[ai][m];
            f32x4 v00 = acc[ai][0][m][0] * ri + b00, v01 = acc[ai][0][m][1] * ri + b01, v10 = acc[ai][1][m][0] * ri + b10, v11 = acc[ai][1][m][1] * ri + b11;
            if (KIND < 2) {
                float ss = ((v00.x * v00.x + v00.y * v00.y) + (v00.z * v00.z + v00.w * v00.w)) + ((v01.x * v01.x + v01.y * v01.y) + (v01.z * v01.z + v01.w * v01.w))
                         + ((v10.x * v10.x + v10.y * v10.y) + (v10.z * v10.z + v10.w * v10.w)) + ((v11.x * v11.x + v11.y * v11.y) + (v11.z * v11.z + v11.w * v11.w));
                ss = ::xadd32(::xadd16(ss));
                const float rstd = __builtin_amdgcn_rsqf(ss * (1.f / 64.f) + 1e-6f);
                v00 = v00 * rstd * g00; v01 = v01 * rstd * g01; v10 = v10 * rstd * g10; v11 = v11 * rstd * g11;
                if (lat) {
                    const int t = t0 + dr; const float pr = (float)(t >> 6), pc = (float)(t & 63);
#define ROPE2(A, B, C, REV) do { float x1_ = A.C, x2_ = B.C; rope2(x1_, x2_, REV); A.C = x1_; B.C = x2_; } while (0)
                    ROPE2(v00, v01, x, pr * i0); ROPE2(v00, v01, y, pr * i1); ROPE2(v00, v01, z, pr * i2); ROPE2(v00, v01, w, pr * i3);
                    ROPE2(v10, v11, x, pc * i0); ROPE2(v10, v11, y, pc * i1); ROPE2(v10, v11, z, pc * i2); ROPE2(v10, v11, w, pc * i3);
#undef ROPE2
                }
            }
            if ((KIND == 1 || KIND == 2) && !lat) { *(GAS f32x4*)(cog) = v00; *(GAS f32x4*)(cog + 16) = v01; *(GAS f32x4*)(cog + 32) = v10; *(GAS f32x4*)(cog + 48) = v11; }
            typedef unsigned u32x2 __attribute__((ext_vector_type(2)));
            v00 = v00 * qscale; v01 = v01 * qscale; v10 = v10 * qscale; v11 = v11 * qscale;
            u32x2 w;
            w.x = cvt_pk_bf16(v00.x, v00.y); w.y = cvt_pk_bf16(v00.z, v00.w); *(GAS u32x2*)(dstg) = w;
            w.x = cvt_pk_bf16(v01.x, v01.y); w.y = cvt_pk_bf16(v01.z, v01.w); *(GAS u32x2*)(dstg + 16) = w;
            w.x = cvt_pk_bf16(v10.x, v10.y); w.y = cvt_pk_bf16(v10.z, v10.w); *(GAS u32x2*)(dstg + 32) = w;
            w.x = cvt_pk_bf16(v11.x, v11.y); w.y = cvt_pk_bf16(v11.z, v11.w); *(GAS u32x2*)(dstg + 48) = w;
            if (m & 1) __builtin_amdgcn_sched_barrier(0);
        }
}
struct EpiQKV {
    static constexpr bool PERM = false, AFTER_DRAIN = false;
    unsigned char* ws; float* out; const float *qg, *kg; int layer;
    __device__ __forceinline__ void operator()(const f32x4 (&acc)[2][2][4][2], const Unit& u, int wr, int wc, int fr, int fq) const {
        { int t_ = threadIdx.x; asm volatile("" : "+v"(t_)); fr = t_ & 15; fq = (t_ >> 4) & 3; }
        const int pn = u.pn; const bool lat = u.pm >= 32;
        const int cnd = u.pm < 32 ? 0 : 1 + ((u.pm - 32) >> 3);
        const float* rs0 = (const float*)(ws + WS_RS) + ((size_t)(2 * layer) * 12288 + (u.pm * BM + wr * 64 + fr)) * 4;
        const float* bp = (const float*)(ws + WS_B1) + ((size_t)layer * 3 + cnd) * 1280 + pn * BM + wc * 32 + 4 * fq;
        const int row0 = u.pm * BM + wr * 64 + fr;
        int t0 = (row0 - 8192) & 2047;
        asm volatile("" : "+v"(t0));
        if (pn < 2) {
            qkv_rows<0>(acc, (bf16_t*)(ws + WS_Q) + (size_t)row0 * 512 + (4 * pn + wc) * 64 + 4 * fq, 512, nullptr, qg + 4 * fq, lat, t0, fq, rs0, bp);
        } else if (pn == 2) {
            const int hh = wc & 1; const bool isk = wc < 2;
            size_t doff;
            if (!lat) doff = (isk ? WS_KC : WS_VC) + ((size_t)row0 * 128 + hh * 64) * 2;
            else { const int b = (row0 - 8192) >> 11; doff = (isk ? WS_KL : WS_VL) + (((size_t)(layer * 2 + b) * 2560 + 512 + ((row0 - 8192) & 2047)) * 128 + hh * 64) * 2; }
            bf16_t* dst0 = (bf16_t*)(ws + doff) + 4 * fq;
            float* c0 = out + (size_t)12288 * 1024 + (isk ? 0 : (size_t)32 * 4 * 256 * 128) + ((size_t)((row0 >> 8) * 4 + layer) * 256 + (row0 & 255)) * 128 + hh * 64 + 4 * fq;
            if (isk) qkv_rows<1>(acc, dst0, 128, c0, kg + 4 * fq, lat, t0, fq, rs0, bp); else qkv_rows<2>(acc, dst0, 128, c0, kg, lat, t0, fq, rs0, bp);
        } else {
            qkv_rows<3>(acc, (bf16_t*)(ws + WS_U) + (size_t)row0 * 512 + (pn - 3) * 256 + wc * 64 + 4 * fq, 512, nullptr, kg, lat, t0, fq, rs0, bp);
        }
    }
};
struct EpiRes {
    static constexpr bool PERM = true, AFTER_DRAIN = false;
    unsigned char* ws; const float* gate;
    int ninst;
    PG8_LAS float* XB;
    __device__ __forceinline__ void operator()(const f32x4 (&acc)[2][2][4][2], const Unit& u, int wr, int wc, int fr, int fq) const {
#ifdef PROBE_DUP
        if (ninst == -2) return;
#endif
        int tl; { int t_ = threadIdx.x; asm volatile("" : "+v"(t_)); fr = t_ & 15; fq = (t_ >> 4) & 3; tl = t_; }
        const int cnd = u.pm < 32 ? 0 : 1 + ((u.pm - 32) >> 3);
        const int col0 = u.pn * BM + wc * 32 + 8 * fq; const float* gp = gate + (size_t)cnd * 6144 + col0;
        const float* gm = (const float*)(ws + WS_GM) + ((size_t)(ninst < 0 ? 0 : ninst) * 3 + cnd) * 1024 + col0;
        const int row0 = u.pm * BM + wr * 64 + fr;
        bf16_t* x0 = (bf16_t*)(ws + WS_X) + (size_t)row0 * 1024 + col0;
        bf16_t* h0 = (bf16_t*)(ws + WS_H) + (size_t)row0 * 1024 + col0;
        f32x4 gt[2][2], gn[2][2];
#pragma unroll
        for (int bj = 0; bj < 2; ++bj)
#pragma unroll
            for (int n = 0; n < 2; ++n) { gt[bj][n] = *(const f32x4*)(gp + bj * HALF + 4 * n); gn[bj][n] = *(const f32x4*)(gm + bj * HALF + 4 * n); }
#pragma unroll
        for (int ai = 0; ai < 2; ++ai)
#pragma unroll
            for (int m = 0; m < 4; ++m) { const int dr = ai * HALF + m * 16;
                bf16_t* xr_ = x0; bf16_t* hr_ = h0; asm volatile("" : "+v"(xr_), "+v"(hr_)); GAS bf16_t* xr = (GAS bf16_t*)xr_ + dr * 1024; GAS bf16_t* hr = (GAS bf16_t*)hr_ + dr * 1024;
                float ss = 0.f;
#pragma unroll
                for (int bj = 0; bj < 2; ++bj) {
                    const u32x4 xo = *(const GAS u32x4*)(xr + bj * HALF);
                    const f32x4 o0 = {::h_lo(xo.x), ::h_hi(xo.x), ::h_lo(xo.y), ::h_hi(xo.y)}, o1 = {::h_lo(xo.z), ::h_hi(xo.z), ::h_lo(xo.w), ::h_hi(xo.w)};
                    const f32x4 x0v = o0 + gt[bj][0] * acc[ai][bj][m][0], x1v = o1 + gt[bj][1] * acc[ai][bj][m][1];
                    u32x4 xw; xw.x = ::pkh2(x0v[0], x0v[1]); xw.y = ::pkh2(x0v[2], x0v[3]); xw.z = ::pkh2(x1v[0], x1v[1]); xw.w = ::pkh2(x1v[2], x1v[3]);
                    *(GAS u32x4*)(xr + bj * HALF) = xw;
                    if (ninst >= 0) { ss += ((x0v.x * x0v.x + x0v.y * x0v.y) + (x0v.z * x0v.z + x0v.w * x0v.w)) + ((x1v.x * x1v.x + x1v.y * x1v.y) + (x1v.z * x1v.z + x1v.w * x1v.w));
                        const f32x4 y0 = x0v * gn[bj][0], y1 = x1v * gn[bj][1];
                        u32x4 hw; hw.x = cvt_pk_bf16(y0[0], y0[1]); hw.y = cvt_pk_bf16(y0[2], y0[3]); hw.z = cvt_pk_bf16(y1[0], y1[1]); hw.w = cvt_pk_bf16(y1[2], y1[3]);
                        *(GAS u32x4*)(hr + bj * HALF) = hw; } }
                if (ninst >= 0) { ss = ::xadd32(::xadd16(ss)); if (fq == 0) XB[wc * 256 + wr * 64 + fr + dr] = ss; }
                if (m == 3) asm volatile("" ::: "memory"); }
        if (ninst >= 0) {
            asm volatile("s_waitcnt lgkmcnt(0)" ::: "memory"); __builtin_amdgcn_s_barrier(); asm volatile("" ::: "memory");
            if (tl < 256) { const float s_ = (XB[tl] + XB[256 + tl]) + (XB[512 + tl] + XB[768 + tl]);
                ((float*)(ws + WS_RS))[((size_t)ninst * 12288 + u.pm * BM + tl) * 4 + u.pn] = s_; }
        }
    }
};
struct EpiZ {
    static constexpr bool PERM = true, AFTER_DRAIN = false;
    unsigned char* ws; int layer;
    __device__ __forceinline__ void operator()(const f32x4 (&acc)[2][2][4][2], const Unit& u, int wr, int wc, int fr, int fq) const {
        const int cnd = u.pm < 32 ? 0 : 1 + ((u.pm - 32) >> 3);
        const int row0 = u.pm * BM + wr * 64 + fr, col0 = u.pn * BM + wc * 32 + 8 * fq;
        const float* bias = (const float*)(ws + WS_B5) + ((size_t)layer * 3 + cnd) * 5632 + col0;
        const float* rs0 = (const float*)(ws + WS_RS) + (size_t)(2 * layer + 1) * 12288 + row0;
        bf16_t* z0 = (bf16_t*)(ws + WS_Z) + (size_t)row0 * 5632 + col0;
        f32x4 bv[2][2];
#pragma unroll
        for (int bj = 0; bj < 2; ++bj)
#pragma unroll
            for (int n = 0; n < 2; ++n) bv[bj][n] = *(const f32x4*)(bias + bj * HALF + 4 * n);
#pragma unroll
        for (int ai = 0; ai < 2; ++ai)
#pragma unroll
            for (int m = 0; m < 4; ++m) { const int dr = ai * HALF + m * 16;
                bf16_t* zr_ = z0; const float* rsp = rs0; asm volatile("" : "+v"(zr_), "+v"(rsp)); GAS bf16_t* zr = (GAS bf16_t*)zr_ + (size_t)dr * 5632;
                const float rstd = 1.f / sqrtf(((const GAS float*)rsp)[dr] * (1.f / 1024.f) + 1e-6f);
#pragma unroll
                for (int bj = 0; bj < 2; ++bj) { const f32x4 v0 = acc[ai][bj][m][0] * rstd + bv[bj][0], v1 = acc[ai][bj][m][1] * rstd + bv[bj][1];
                    u32x4 w; w.x = cvt_pk_bf16(v0[0], v0[1]); w.y = cvt_pk_bf16(v0[2], v0[3]); w.z = cvt_pk_bf16(v1[0], v1[1]); w.w = cvt_pk_bf16(v1[2], v1[3]);
                    *(GAS u32x4*)(zr + bj * HALF) = w; } }
    }
};
template <int CTRL> __device__ __forceinline__ f32x4 dpp4(const f32x4 v) { f32x4 r;
#pragma unroll
    for (int c = 0; c < 4; ++c) r[c] = __int_as_float(__builtin_amdgcn_update_dpp(0, __float_as_int(v[c]), CTRL, 0xf, 0xf, false)); return r; }
struct EpiConv {
    static constexpr bool PERM = true, AFTER_DRAIN = false;
    unsigned char* ws; const float* cw; const float* cb; PG8_LAS float* XB; int layer;
    __device__ __forceinline__ void operator()(f32x4 (&acc)[2][2][4][2], const Unit& u, int wr, int wc, int fr, int fq) const {
        int tl; { int t_ = threadIdx.x; asm volatile("" : "+v"(t_)); fr = t_ & 15; fq = (t_ >> 4) & 3; tl = t_; }
        PG8_LAS float* WL = XB + 2048;
        float wl0, wl1; { const int k0 = tl >> 7, k1 = k0 + 4, c = tl & 127; const unsigned cbase = (unsigned)(u.pn * HALF + c);
            wl0 = k0 < 3 ? cw[cbase + (unsigned)(k0 * 5632)] : cb[cbase];
            wl1 = k0 < 3 ? cw[cbase + (unsigned)(k0 * 5632 + 2816)] : cb[cbase + 2816u]; (void)k1; }
        const int cnd = u.pm < 32 ? 0 : 1 + ((u.pm - 32) >> 3); const bool lat = u.pm >= 32;
        const int ci0 = wc * 32 + 8 * fq, row0 = u.pm * BM + wr * 64 + fr;
        {
            const float* bias = (const float*)(ws + WS_B5) + ((size_t)layer * 3 + cnd) * 5632 + u.pn * BM + ci0;
            const float* rs0 = (const float*)(ws + WS_RS) + ((size_t)(2 * layer + 1) * 12288 + row0) * 4;
            float rstd[2][4];
#pragma unroll
            for (int ai = 0; ai < 2; ++ai) {
#pragma unroll
                for (int m = 0; m < 4; ++m) { const f32x4 p_ = *(const f32x4*)(rs0 + (ai * HALF + m * 16) * 4); rstd[ai][m] = __builtin_amdgcn_rsqf(((p_.x + p_.y) + (p_.z + p_.w)) * (1.f / 1024.f) + 1e-6f); }
                asm volatile("" : "+v"(rstd[ai][0]), "+v"(rstd[ai][1]), "+v"(rstd[ai][2]), "+v"(rstd[ai][3]) :: "memory");
            }
#pragma unroll
            for (int bj = 0; bj < 2; ++bj) {
                const f32x4 b0 = *(const f32x4*)(bias + bj * HALF), b1 = *(const f32x4*)(bias + bj * HALF + 4);
#pragma unroll
                for (int ai = 0; ai < 2; ++ai)
#pragma unroll
                    for (int m = 0; m < 4; ++m) { acc[ai][bj][m][0] = acc[ai][bj][m][0] * rstd[ai][m] + b0; acc[ai][bj][m][1] = acc[ai][bj][m][1] * rstd[ai][m] + b1; }
                asm volatile("" ::: "memory");
            }
        }
#pragma unroll
        for (int ai = 0; ai < 2; ++ai) { const int blk = 2 * ai + wr;
#pragma unroll
            for (int bj = 0; bj < 2; ++bj)
#pragma unroll
                for (int n = 0; n < 2; ++n) {
                    if (fr == 0) *(PG8_LAS f32x4*)(XB + (blk * 2 + 0) * 256 + bj * HALF + ci0 + 4 * n) = acc[ai][bj][0][n];
                    if (fr == 15) *(PG8_LAS f32x4*)(XB + (blk * 2 + 1) * 256 + bj * HALF + ci0 + 4 * n) = acc[ai][bj][3][n]; } }
        if (lat) { float* hb = (float*)(ws + WS_HALO) + (size_t)(u.pm - 32) * 4 * 5632 + u.pn * BM + ci0;
            if (wr == 0 && fr < 2) {
#pragma unroll
                for (int bj = 0; bj < 2; ++bj)
#pragma unroll
                    for (int n = 0; n < 2; ++n) *(f32x4*)(hb + (size_t)fr * 5632 + bj * HALF + 4 * n) = acc[0][bj][0][n]; }
            if (wr == 1 && fr >= 14) {
#pragma unroll
                for (int bj = 0; bj < 2; ++bj)
#pragma unroll
                    for (int n = 0; n < 2; ++n) *(f32x4*)(hb + (size_t)(fr - 12) * 5632 + bj * HALF + 4 * n) = acc[1][bj][3][n]; } }
        WL[tl] = wl0; WL[512 + tl] = wl1;
        asm volatile("s_waitcnt lgkmcnt(0)" ::: "memory"); __builtin_amdgcn_s_barrier(); asm volatile("" ::: "memory");
        const int ch0 = u.pn * HALF + ci0;
        bf16_t* actb = (bf16_t*)(ws + WS_ACT); const unsigned aoff0 = (unsigned)(row0 * 2816 + ch0);
#pragma unroll
        for (int n = 0; n < 2; ++n) {
#pragma unroll
            for (int ai = 0; ai < 2; ++ai) { const int blk = 2 * ai + wr;
#pragma unroll
                for (int bj = 0; bj < 2; ++bj) {
                    const PG8_LAS float* wlp = WL + bj * 512 + ci0 + 4 * n;
                    const f32x4 w0 = *(const PG8_LAS f32x4*)(wlp), w1 = *(const PG8_LAS f32x4*)(wlp + 128), w2 = *(const PG8_LAS f32x4*)(wlp + 256), bb = *(const PG8_LAS f32x4*)(wlp + 384);
                    f32x4 edge_prev = {0.f, 0.f, 0.f, 0.f}, edge_next = {0.f, 0.f, 0.f, 0.f};
                    if (blk > 0) edge_prev = *(const PG8_LAS f32x4*)(XB + ((blk - 1) * 2 + 1) * 256 + bj * HALF + ci0 + 4 * n);
                    if (blk < 3) edge_next = *(const PG8_LAS f32x4*)(XB + ((blk + 1) * 2 + 0) * 256 + bj * HALF + ci0 + 4 * n);
                    f32x4 orig = edge_prev;
#pragma unroll
                    for (int m = 0; m < 4; ++m) {
                        const f32x4 z = acc[ai][bj][m][n];
                        f32x4 pv = dpp4<0x121>(z), nx = dpp4<0x12F>(z);
                        const f32x4 e = m > 0 ? dpp4<0x121>(orig) : edge_prev;
                        const f32x4 g = m < 3 ? dpp4<0x12F>(acc[ai][bj][m < 3 ? m + 1 : 3][n]) : edge_next;
                        if (fr == 0) pv = e;
                        if (fr == 15) nx = g;
                        acc[ai][bj][m][n] = pv * w0 + z * w1 + nx * w2 + bb;
                        orig = z;
                    }
                    __builtin_amdgcn_sched_barrier(0); asm volatile("" ::: "memory");
                }
#pragma unroll
                for (int m = 0; m < 4; ++m) { const f32x4 av = acc[ai][0][m][n], gv = acc[ai][1][m][n]; f32x4 o;
#pragma unroll
                    for (int c = 0; c < 4; ++c) o[c] = av[c] * __builtin_amdgcn_rcpf(1.f + __expf(-av[c])) * gv[c];
                    typedef unsigned u32x2 __attribute__((ext_vector_type(2))); u32x2 w; w.x = cvt_pk_bf16(o[0], o[1]); w.y = cvt_pk_bf16(o[2], o[3]);
                    { unsigned ao_ = aoff0; asm volatile("" : "+v"(ao_)); *(u32x2*)(actb + (ao_ + (unsigned)((ai * HALF + m * 16) * 2816 + 4 * n))) = w; }
                }
                __builtin_amdgcn_sched_barrier(0); asm volatile("" ::: "memory");
            }
        }
    }
};
}

__device__ __forceinline__ void conv_fixup(unsigned char* ws, const float* cw, const float* cb, int pm, int tid) {
    const int lt = pm - 32, tq = lt & 7; const float* H = (const float*)(ws + WS_HALO); bf16* ACT = (bf16*)(ws + WS_ACT);
#pragma unroll
    for (int rep = 0; rep < 3; ++rep) { const int idx = tid + rep * NTHR;
        if (idx < 2 * (DFF / 4)) {
            const int which = idx >= DFF / 4, ch = (idx - which * (DFF / 4)) * 4;
            if (!((which == 0 && tq == 0) || (which == 1 && tq == 7))) {
                const int pa = (ch >> 7) * 256 + (ch & 127), pg = pa + 128;
                const float *zp, *zc, *zn;
                if (which == 0) { zp = H + (size_t)((lt - 1) * 4 + 3) * NUP; zc = H + (size_t)(lt * 4 + 0) * NUP; zn = H + (size_t)(lt * 4 + 1) * NUP; }
                else { zp = H + (size_t)(lt * 4 + 2) * NUP; zc = H + (size_t)(lt * 4 + 3) * NUP; zn = H + (size_t)((lt + 1) * 4 + 0) * NUP; }
                const f32x4 av = *(const f32x4*)(zp + pa) * *(const f32x4*)(cw + ch) + *(const f32x4*)(zc + pa) * *(const f32x4*)(cw + NUP + ch) + *(const f32x4*)(zn + pa) * *(const f32x4*)(cw + 2 * NUP + ch) + *(const f32x4*)(cb + ch);
                const f32x4 gv = *(const f32x4*)(zp + pg) * *(const f32x4*)(cw + DFF + ch) + *(const f32x4*)(zc + pg) * *(const f32x4*)(cw + NUP + DFF + ch) + *(const f32x4*)(zn + pg) * *(const f32x4*)(cw + 2 * NUP + DFF + ch) + *(const f32x4*)(cb + DFF + ch);
                f32x4 o;
#pragma unroll
                for (int c = 0; c < 4; ++c) o[c] = av[c] / (1.f + __expf(-av[c])) * gv[c];
                v2u w; w.x = pk2(o[0], o[1]); w.y = pk2(o[2], o[3]);
                *(v2u*)(ACT + (size_t)(pm * 256 + (which ? 255 : 0)) * DFF + ch) = w;
            }
        }
    }
    asm volatile("s_waitcnt vmcnt(0)" ::: "memory"); __syncthreads();
}

template <int W> __device__ __forceinline__ void pool_item(const bf16* U, bf16* AO, int r0, int ch) {
    constexpr int HW = W / 2, NR = 8 + W - 1;
    int s0, L; if (r0 < NCTX) { s0 = r0 & ~255; L = 256; } else { s0 = NCTX + ((r0 - NCTX) & ~2047); L = 2048; }
    const int t0 = r0 - s0;
    v4u x[NR];
#pragma unroll
    for (int i = 0; i < NR; ++i) { const int t = t0 - HW + i; x[i] = (v4u){0u, 0u, 0u, 0u}; if (t >= 0 && t < L) x[i] = *(const v4u*)(U + (size_t)(s0 + t) * 512 + ch * 8); }
#define PL_LO(V_) ((f32x4){bf_lo((V_).x), bf_hi((V_).x), bf_lo((V_).y), bf_hi((V_).y)})
#define PL_HI(V_) ((f32x4){bf_lo((V_).z), bf_hi((V_).z), bf_lo((V_).w), bf_hi((V_).w)})
    f32x4 s0v = {0.f, 0.f, 0.f, 0.f}, s1v = s0v;
#pragma unroll
    for (int i = 0; i < W; ++i) { s0v += PL_LO(x[i]); s1v += PL_HI(x[i]); }
#pragma unroll
    for (int i = 0; i < 8; ++i) {
        const int t = t0 + i; const float rc = 1.f / (float)(min(t + HW, L) - max(t - HW, 0));
        const f32x4 o0 = s0v * rc - PL_LO(x[i + HW]), o1 = s1v * rc - PL_HI(x[i + HW]);
        v4u o; o.x = pk2(o0.x, o0.y); o.y = pk2(o0.z, o0.w); o.z = pk2(o1.x, o1.y); o.w = pk2(o1.z, o1.w);
        *(v4u*)(AO + (size_t)(r0 + i) * 1024 + 512 + ch * 8) = o;
        if (i < 7) { s0v += PL_LO(x[i + W]) - PL_LO(x[i]); s1v += PL_HI(x[i + W]) - PL_HI(x[i]); }
    }
#undef PL_LO
#undef PL_HI
}
__device__ __forceinline__ void pool_phase(unsigned char* ws, int gtid, int NT_) {
    const bf16* U = (const bf16*)(ws + WS_U); bf16* AO = (bf16*)(ws + WS_AO);
    constexpr int PER_G = (M / 8) * 16;
    for (int it = gtid; it < 4 * PER_G; it += NT_) {
        const int g = it / PER_G, rem = it % PER_G, ch = g * 16 + (rem & 15), r0 = (rem >> 4) * 8;
        if (g == 0) pool_item<2>(U, AO, r0, ch); else if (g == 1) pool_item<4>(U, AO, r0, ch); else if (g == 2) pool_item<8>(U, AO, r0, ch); else pool_item<16>(U, AO, r0, ch);
    }
}

__device__ __forceinline__ void conv_phase(const Args& a, int l, int gtid, int NT_) {
    size_t wz_ = 0; asm volatile("" : "+s"(wz_)); unsigned char* ws = a.ws + wz_;     const bf16* Z = (const bf16*)(ws + WS_Z); bf16* ACT = (bf16*)(ws + WS_ACT);
    const float* cw = ain(a, I_CW) + (size_t)l * 3 * NUP; const float* cb = ain(a, I_CB) + (size_t)l * NUP;
    constexpr int NCH = DFF / 8, RUN = 8;
    for (int it = gtid; it < (M / RUN) * NCH; it += NT_) {
        const int ch = it % NCH, run = it / NCH, r0 = run * RUN, c0 = ch * 8;
        const int L = r0 < NCTX ? 256 : 2048; const int t0 = (r0 < NCTX ? r0 : r0 - NCTX) & (L - 1);
        v4u za[RUN + 2], zg[RUN + 2];
#pragma unroll
        for (int i = 0; i < RUN + 2; ++i) { const int t = t0 + i - 1; const bool ok = (t >= 0) && (t < L);
            const bf16* p = Z + (size_t)(r0 + i - 1) * NUP + c0;
            za[i] = (v4u){0u, 0u, 0u, 0u}; zg[i] = za[i];
            if (ok) { za[i] = *(const v4u*)p; zg[i] = *(const v4u*)(p + DFF); } }
        f32x4 wa[3][2], wg[3][2], ba[2], bg[2];
#pragma unroll
        for (int k = 0; k < 3; ++k)
#pragma unroll
            for (int q = 0; q < 2; ++q) { wa[k][q] = *(const f32x4*)(cw + (size_t)k * NUP + c0 + 4 * q); wg[k][q] = *(const f32x4*)(cw + (size_t)k * NUP + DFF + c0 + 4 * q); }
#pragma unroll
        for (int q = 0; q < 2; ++q) { ba[q] = *(const f32x4*)(cb + c0 + 4 * q); bg[q] = *(const f32x4*)(cb + DFF + c0 + 4 * q); }
#define CV_LO(V_) ((f32x4){bf_lo((V_).x), bf_hi((V_).x), bf_lo((V_).y), bf_hi((V_).y)})
#define CV_HI(V_) ((f32x4){bf_lo((V_).z), bf_hi((V_).z), bf_lo((V_).w), bf_hi((V_).w)})
#pragma unroll
        for (int i = 0; i < RUN; ++i) {
            const f32x4 a0 = CV_LO(za[i]) * wa[0][0] + CV_LO(za[i + 1]) * wa[1][0] + CV_LO(za[i + 2]) * wa[2][0] + ba[0];
            const f32x4 a1 = CV_HI(za[i]) * wa[0][1] + CV_HI(za[i + 1]) * wa[1][1] + CV_HI(za[i + 2]) * wa[2][1] + ba[1];
            const f32x4 g0 = CV_LO(zg[i]) * wg[0][0] + CV_LO(zg[i + 1]) * wg[1][0] + CV_LO(zg[i + 2]) * wg[2][0] + bg[0];
            const f32x4 g1 = CV_HI(zg[i]) * wg[0][1] + CV_HI(zg[i + 1]) * wg[1][1] + CV_HI(zg[i + 2]) * wg[2][1] + bg[1];
            f32x4 o0, o1;
#pragma unroll
            for (int c = 0; c < 4; ++c) { o0[c] = a0[c] * __builtin_amdgcn_rcpf(1.f + __expf(-a0[c])) * g0[c]; o1[c] = a1[c] * __builtin_amdgcn_rcpf(1.f + __expf(-a1[c])) * g1[c]; }
            v4u ov; ov.x = pk2(o0.x, o0.y); ov.y = pk2(o0.z, o0.w); ov.z = pk2(o1.x, o1.y); ov.w = pk2(o1.z, o1.w);
            *(v4u*)(ACT + (size_t)(r0 + i) * DFF + c0) = ov;
        }
#undef CV_LO
#undef CV_HI
    }
}
#define XB_TMO      128
#define XB_XCNT(j)  (256  + 64 * (j))
#define XB_XSUB(j)  (1280 + 64 * (j))
#define XB_XGEN(j)  (2304 + 64 * (j))
#define XB_TOP      3328
#define XB_TOPGEN   3392
#define XCD_BAR_WORDS 3456
#define XB_SPIN_CAP (1u << 18)

__device__ __forceinline__ unsigned xb_ld(unsigned* p)              { return __hip_atomic_load(p, __ATOMIC_RELAXED, __HIP_MEMORY_SCOPE_AGENT); }
__device__ __forceinline__ unsigned xb_add(unsigned* p, unsigned v) { return __hip_atomic_fetch_add(p, v, __ATOMIC_RELAXED, __HIP_MEMORY_SCOPE_AGENT); }
__device__ __forceinline__ unsigned xb_xcc_id() { return (unsigned)__builtin_amdgcn_s_getreg((3 << 11) | 20) & 0xFu; }
#define XB_SPIN(cond, bar) do { unsigned _sp = 0; while (cond) { __builtin_amdgcn_s_sleep(1); \
    if ((++_sp & 255u) == 0u) { if (xb_ld(&(bar)[XB_TMO])) break; if (_sp > XB_SPIN_CAP) { atomicAdd(&(bar)[XB_TMO], 1u); break; } } } } while (0)

struct XcdBarrier {
    unsigned* bar; unsigned x;
    volatile LAS unsigned* st;
};

__device__ __forceinline__ XcdBarrier xcd_barrier_post(unsigned* bar, volatile LAS unsigned* st) {
    XcdBarrier b; b.bar = bar; b.x = xb_xcc_id(); b.st = st;
    if (threadIdx.x == 0) (void)xb_add(&bar[XB_XCNT(b.x)], 1u);
    return b;
}
__device__ __forceinline__ void xcd_barrier_complete(unsigned* bar, unsigned x, unsigned& nloc, unsigned& nx) {
    const unsigned G = gridDim.x * gridDim.y * gridDim.z;
    unsigned sum, cnt, mine, sp = 0u;
    for (;;) {
        sum = 0u; cnt = 0u; mine = 0u;
#pragma unroll
        for (unsigned j = 0; j < 16; ++j) { const unsigned c = xb_ld(&bar[XB_XCNT(j)]); sum += c; cnt += (c > 0u) ? 1u : 0u; mine = (j == x) ? c : mine; }
        if (sum == G) break;
        __builtin_amdgcn_s_sleep(1);
        if ((++sp & 255u) == 0u) { if (xb_ld(&bar[XB_TMO])) break; if (sp > XB_SPIN_CAP) { atomicAdd(&bar[XB_TMO], 1u); break; } }
    }
    nloc = mine > 0u ? mine : 1u; nx = cnt > 0u ? cnt : 1u;
}

__device__ __forceinline__ void xcd_barrier(const XcdBarrier& b) {
    asm volatile("s_waitcnt vmcnt(0)" ::: "memory");
    __syncthreads();
    if (threadIdx.x == 0) {
        unsigned* bar = b.bar;
        __builtin_amdgcn_s_waitcnt(0);
        unsigned nloc = b.st[0], nx = b.st[1];
        if (nloc == 0u) { xcd_barrier_complete(bar, b.x, nloc, nx); b.st[0] = nloc; b.st[1] = nx; }
        const unsigned old = xb_add(&bar[XB_XSUB(b.x)], 1u);
        const unsigned gen = old / nloc;
        if (old + 1u == (gen + 1u) * nloc) {
            __builtin_amdgcn_fence(__ATOMIC_RELEASE, "agent");
            asm volatile("s_waitcnt vmcnt(0)" ::: "memory");
            const unsigned og = xb_add(&bar[XB_TOP], 1u);
            const unsigned tg = og / nx;
            if (og + 1u == (tg + 1u) * nx) xb_add(&bar[XB_TOPGEN], 1u);
            else XB_SPIN(xb_ld(&bar[XB_TOPGEN]) == tg, bar);
            __builtin_amdgcn_fence(__ATOMIC_ACQUIRE, "agent");
            xb_add(&bar[XB_XGEN(b.x)], 1u);
            asm volatile("s_waitcnt vmcnt(0)" ::: "memory");
        } else {
            XB_SPIN(xb_ld(&bar[XB_XGEN(b.x)]) == gen, bar);
            __builtin_amdgcn_fence(__ATOMIC_ACQUIRE, "agent");
            asm volatile("s_waitcnt vmcnt(0)" ::: "memory");
        }
    }
    __syncthreads();
}

#ifdef SKIP0
#define SK0(...) do{}while(0)
#else
#define SK0(...) __VA_ARGS__
#endif
#ifdef SKIP1
#define SK1(...) do{}while(0)
#else
#define SK1(...) __VA_ARGS__
#endif
#ifdef SKIP2
#define SK2(...) do{}while(0)
#else
#define SK2(...) __VA_ARGS__
#endif
#ifdef SKIP3
#define SK3(...) do{}while(0)
#else
#define SK3(...) __VA_ARGS__
#endif
#ifdef SKIP4
#define SK4(...) do{}while(0)
#else
#define SK4(...) __VA_ARGS__
#endif
#ifdef SKIP5
#define SK5(...) do{}while(0)
#else
#define SK5(...) __VA_ARGS__
#endif
constexpr int NPH_L = 5;
constexpr int NPHASE = 2 + NPH_L * DEPTH + 1;
__global__ void __launch_bounds__(NTHR, 2) mega_fwd(Args a) {
    extern __shared__ __attribute__((aligned(16))) unsigned char lds_raw[];
    cg::grid_group grid = cg::this_grid();
    LAS unsigned char* lds = (LAS unsigned char*)lds_raw;
    volatile LAS unsigned* bst = (volatile LAS unsigned*)(lds + 131072 + 64);
    if (threadIdx.x < 2) bst[threadIdx.x] = 0u;
    __syncthreads();
    XcdBarrier xbar = xcd_barrier_post((unsigned*)a.ws, bst);
#ifdef PROBE_DUP
    for (int ph2 = 2 * a.ph_lo; ph2 < 2 * a.ph_hi; ++ph2) {
        const int ph = ph2 >> 1;
        if ((ph2 & 1) && !(ph >= 2 && ph < NPHASE - 1 && (ph - 2) % NPH_L == PROBE_DUP)) continue;
#else
    for (int ph = a.ph_lo; ph < a.ph_hi; ++ph) {
#endif
        int G = gridDim.x, bx = blockIdx.x; asm volatile("" : "+s"(G), "+s"(bx));
        const int vcu = (G % 8 == 0) ? (bx % 8) * (G / 8) + bx / 8 : bx;
        const int NGW = G * NWAVES, NGT = G * NTHR;
        const int n_idle = G - 192; const bool defer = n_idle >= 32; const int nl_pre = defer ? 1 : DEPTH;
#define TIDS() int tid = threadIdx.x; asm volatile("" : "+v"(tid)); const int lane = tid & 63, wave = __builtin_amdgcn_readfirstlane(tid >> 6); const int gw = vcu * NWAVES + wave, gtid = vcu * NTHR + tid; (void)lane; (void)gw; (void)gtid
        size_t wz_ = 0; asm volatile("" : "+s"(wz_)); unsigned char* ws = a.ws + wz_;
        float* mod = (float*)(ws + WS_MOD);
        if (ph == 0) { TIDS(); SK0(prologue(a, lds, vcu, G, tid, lane, wave, nl_pre)); }
        else if (ph == 1) { TIDS(); phase1(a, gw, NGW, lane, nl_pre); }
        else if (ph == NPHASE - 1) { TIDS(); final_norm(a, gw, NGW, lane); }
        else {
            const int l = (ph - 2) / NPH_L, s = (ph - 2) % NPH_L;
            if (s == 0) {
                pg8::Gemm g{(const pg8::bf16_t*)(ws + WS_H), (const pg8::bf16_t*)(ws + WS_WIN) + (size_t)l * NIN * D, M, NIN, D};
                pg8::StaticOrder S; S.init(M, NIN, G, bx);
                pg8::EpiQKV E{ws, a.out, ain(a, I_QG) + l * 64, ain(a, I_KG) + l * 64, l};
                SK1(pg8::gemm_phase<pg8::EpiQKV, pg8::StaticOrder, true, true>(lds, g, S, E));
            } else if (s == 1) {
                TIDS();
#ifndef ATT_SPLIT
                pool_phase(ws, gtid, NGT);
                const attn_body::bf16* Qb = (const attn_body::bf16*)(ws + WS_Q); attn_body::bf16* AOb = (attn_body::bf16*)(ws + WS_AO);
                for (int idx = vcu; idx < 512; idx += G) {
                    const attn_body::bf16 *Q0, *Kh, *Vh; attn_body::bf16* O0; int NT, ncomp;
                    if (idx < 256) { const int b = idx >> 7, h = (idx >> 4) & 7, qb = idx & 15; const size_t r0 = (size_t)NCTX + b * LSEQ + qb * 128;
                        Q0 = Qb + r0 * 512 + h * 64; O0 = AOb + r0 * 1024 + h * 64; NT = LKEYS / 64; ncomp = 4;
                        Kh = (const attn_body::bf16*)(ws + WS_KL) + ((size_t)(l * 2 + b) * LKEYS) * 128 + (h >> 2) * 64;
                        Vh = (const attn_body::bf16*)(ws + WS_VL) + ((size_t)(l * 2 + b) * LKEYS) * 128 + (h >> 2) * 64;
                    } else { const int u = idx - 256, b = u >> 3, h = u & 7; const size_t r0 = (size_t)b * SEQ;
                        Q0 = Qb + r0 * 512 + h * 64; O0 = AOb + r0 * 1024 + h * 64; NT = SEQ / 64; ncomp = 8;
                        Kh = (const attn_body::bf16*)(ws + WS_KC) + r0 * 128 + (h >> 2) * 64;
                        Vh = (const attn_body::bf16*)(ws + WS_VC) + r0 * 128 + (h >> 2) * 64; }
                    SK2(attn_body::attn_unit<8>(Q0, Kh, Vh, O0, NT, (char*)lds_raw, 0, nullptr, nullptr, nullptr, ncomp));
                }
#else
                pool_phase(ws, gtid, NGT);
                const attn_body::bf16* Qb = (const attn_body::bf16*)(ws + WS_Q); attn_body::bf16* AOb = (attn_body::bf16*)(ws + WS_AO);
                for (int idx = vcu; idx < 512; idx += G) {
                    const attn_body::bf16 *Q0, *Kh, *Vh; attn_body::bf16* O0; int NT, split = 0; float* part = nullptr; const float* partner = nullptr; unsigned* cnt = nullptr;
                    if (idx < 256) { const int un = idx >> 1, hf = idx & 1, b = un >> 6, h = (un >> 3) & 7, qb = un & 7; const size_t r0 = (size_t)NCTX + b * LSEQ + qb * 256;
                        Q0 = Qb + r0 * 512 + h * 64; O0 = AOb + r0 * 1024 + h * 64; NT = LKEYS / 128; split = 1;
                        Kh = (const attn_body::bf16*)(ws + WS_KL) + ((size_t)(l * 2 + b) * LKEYS + hf * (LKEYS / 2)) * 128 + (h >> 2) * 64;
                        Vh = (const attn_body::bf16*)(ws + WS_VL) + ((size_t)(l * 2 + b) * LKEYS + hf * (LKEYS / 2)) * 128 + (h >> 2) * 64;
                        part = (float*)(ws + WS_APART) + (size_t)idx * APART_FLOATS; partner = (const float*)(ws + WS_APART) + (size_t)(idx ^ 1) * APART_FLOATS;
                        cnt = (unsigned*)(ws + WS_ACNT) + ((size_t)l * 128 + un) * 8;
                    } else { const int u = idx - 256, b = u >> 3, h = u & 7; const size_t r0 = (size_t)b * SEQ;
                        Q0 = Qb + r0 * 512 + h * 64; O0 = AOb + r0 * 1024 + h * 64; NT = SEQ / 64;
                        Kh = (const attn_body::bf16*)(ws + WS_KC) + r0 * 128 + (h >> 2) * 64;
                        Vh = (const attn_body::bf16*)(ws + WS_VC) + r0 * 128 + (h >> 2) * 64; }
                    SK2(attn_body::attn_unit<8>(Q0, Kh, Vh, O0, NT, (char*)lds_raw, split, part, partner, cnt, 8));
                }
#endif
            } else if (s == 2 || s == 4) {
                const bool dn = (s == 4);
                pg8::Gemm g{(const pg8::bf16_t*)(ws + (dn ? WS_ACT : WS_AO)), dn ? (const pg8::bf16_t*)(ws + WS_WDN) + (size_t)l * D * DFF : (const pg8::bf16_t*)(ws + WS_WOUT) + (size_t)l * D * D, M, D, dn ? DFF : D};
                pg8::StaticOrder S; S.init(M, D, G, bx);
                if (defer && bx >= 192) {
                    TIDS(); const int iw = (bx - 192) * NWAVES + wave, NIW = n_idle * NWAVES;
                    if (!dn) { if (l + 1 < DEPTH) convert_layer(a, ws, lds, iw, NIW, lane, wave, l + 1, 0);
                               if (l >= 1) bias_rows(ws, iw, NIW, lane, l, true); }
                    else if (l + 1 < DEPTH) { convert_layer(a, ws, lds, iw, NIW, lane, wave, l + 1, 1); weff_layer(a, ws, lds, iw, NIW, lane, wave, l + 1);
                                              bias_rows(ws, iw, NIW, lane, l + 1, false); }
                }
                if (dn) { TIDS(); pg8::Unit u0; if (S.next(0, u0) && u0.pm >= 32) conv_fixup(ws, ain(a, I_CW) + (size_t)l * 3 * NUP, ain(a, I_CB) + (size_t)l * NUP, u0.pm, tid); }
                pg8::EpiRes E{ws, mod + (size_t)l * 3 * NMOD + (dn ? 5 : 2) * D, dn ? (l + 1 < DEPTH ? 2 * (l + 1) : -1) : 2 * l + 1, (PG8_LAS float*)(lds + 131072 + 1024)};
#ifdef PROBE_DUP
                if (ph2 & 1) E.ninst = -2;
#endif
                SK3(pg8::gemm_phase<pg8::EpiRes, pg8::StaticOrder, true, true>(lds, g, S, E));
            } else {
                pg8::Gemm g{(const pg8::bf16_t*)(ws + WS_H), (const pg8::bf16_t*)(ws + WS_WUP) + (size_t)l * NUP * D, M, NUP, D};
                pg8::StaticOrder S; S.init(M, NUP, G, bx);
                pg8::EpiConv E{ws, ain(a, I_CW) + (size_t)l * 3 * NUP, ain(a, I_CB) + (size_t)l * NUP, (PG8_LAS float*)(lds + 131072 + 1024), l};
                SK4(pg8::gemm_phase<pg8::EpiConv, pg8::StaticOrder, true, true>(lds, g, S, E));
            }
        }
#ifdef PROBE_DUP
        if (ph2 + 1 < 2 * a.ph_hi) {
#else
        if (ph + 1 < a.ph_hi) {
#endif: the first one is cg grid.sync() (marks the kernel cooperative for the replay), the rest the XCD-aware barrier
            if (a.ph_hi < 0) grid.sync();
            xcd_barrier(xbar);
#ifdef PROBE_SYNC2
            xcd_barrier(xbar);
#endif
        }
    }
}

#ifndef MK_MULTI
#define MK_MULTI 0
#endif
extern "C" void kernel_launch(void* const* d_in, const int* in_sizes, int n_in, void* d_out, int out_size, void* d_ws, size_t ws_size, hipStream_t stream) {
    static int grid = 0;
    if (grid == 0) {
        if (n_in != 21 || ws_size < WS_END) { fprintf(stderr, "kernel_launch: unexpected n_in %d / ws_size %zu\n", n_in, ws_size); grid = -1; return; }
        int dev = 0, cus = 0, per_cu = 0;
        hipGetDevice(&dev); hipDeviceGetAttribute(&cus, hipDeviceAttributeMultiprocessorCount, dev);
        if (hipFuncSetAttribute((const void*)mega_fwd, hipFuncAttributeMaxDynamicSharedMemorySize, LDS_BYTES) != hipSuccess) { fprintf(stderr, "kernel_launch: hipFuncSetAttribute failed\n"); grid = -1; return; }
        if (hipOccupancyMaxActiveBlocksPerMultiprocessor(&per_cu, (const void*)mega_fwd, NTHR, LDS_BYTES) != hipSuccess || per_cu < 1) { fprintf(stderr, "kernel_launch: occupancy query says %d\n", per_cu); (void)hipGetLastError(); grid = -1; return; }
        grid = cus * per_cu;
        fprintf(stderr, "kernel_launch: grid %d (cus %d x %d)\n", grid, cus, per_cu);
    }
    if (grid < 0) return;
    Args a{};
    for (int i = 0; i < 21; ++i) a.in[i] = (const float*)d_in[i];
    a.out = (float*)d_out; a.ws = (unsigned char*)d_ws;
#if MK_MULTI
    for (int ph = 0; ph < NPHASE; ++ph) { a.ph_lo = ph; a.ph_hi = ph + 1; hipLaunchKernelGGL(mega_fwd, dim3(grid), dim3(NTHR), LDS_BYTES, stream, a); }
#else
    a.ph_lo = 0; a.ph_hi = NPHASE;
    if (hipMemsetAsync(d_ws, 0, 16384, stream) != hipSuccess) { fprintf(stderr, "kernel_launch: memset failed\n"); return; }
    void* args[] = {&a};
    hipError_t e = hipLaunchCooperativeKernel((const void*)mega_fwd, dim3(grid), dim3(NTHR), args, LDS_BYTES, stream);
    if (e != hipSuccess) fprintf(stderr, "cooperative launch failed: %s (grid %d)\n", hipGetErrorString(e), grid);
#endif
}
```

```cpp
#include <hip/hip_runtime.h>
#include <hip/hip_cooperative_groups.h>
#include <cstdio>
#include <cstdint>
namespace cg = cooperative_groups;
#define MK_MULTI 0
namespace pg8 {
#define PG8_LAS __attribute__((address_space(3)))
typedef unsigned short bf16_t;
typedef short bf16x8 __attribute__((ext_vector_type(8)));
typedef float f32x4 __attribute__((ext_vector_type(4)));
typedef unsigned u32x4 __attribute__((ext_vector_type(4)));
constexpr int BM = 256, BK = 64, HALF = 128, HTB = HALF * BK * 2  , STAGE_BYTES = 8 * HTB, NXCD = 8, WGM = 6;

__host__ __device__ __forceinline__ int lds_byte(int r, int c) { const int st = (r >> 4) * 2 + (c >> 5), rr = r & 15, cc = c & 31, ob = rr * 64 + cc * 2; return st * 1024 + (ob ^ (((ob >> 9) & 1) << 5)); }
__host__ __device__ __forceinline__ void stage_rc(int b, int& R, int& C) { const int st = b / 1024, sb = b % 1024, swz = sb ^ (((sb >> 9) & 1) << 5); R = (st >> 1) * 16 + swz / 64; C = (st & 1) * 32 + (swz % 64) / 2; }
__host__ __device__ __forceinline__ int perm32(int rho) { const int n = rho >> 4, i = rho & 15; return 8 * (i >> 2) + 4 * n + (i & 3); }

struct Unit { int pm, pn; };
struct Gemm { const bf16_t* A; const bf16_t* Bt; int M, N, K; };

struct StaticOrder {
    int nM, nN, nwg, G, c;
    __host__ __device__ void init(int M, int N, int G_, int c_) { nM = M / BM; nN = N / BM; nwg = nM * nN; G = G_; c = c_; }
    __host__ __device__ bool next(int i, Unit& u) const {
        const long L = (long)i * G + c; if (L >= nwg) return false;
        int wgid = (int)L; { const int q = nwg / NXCD, r = nwg % NXCD, xcd = wgid % NXCD, off = wgid / NXCD; wgid = (xcd < r ? xcd * (q + 1) : r * (q + 1) + (xcd - r) * q) + off; }
        const int nig = WGM * nN, gid = wgid / nig, fm = gid * WGM, gsz = (nM - fm) < WGM ? (nM - fm) : WGM;
        u.pm = fm + ((wgid % nig) % gsz); u.pn = (wgid % nig) / gsz; return true;
    }
    __device__ __forceinline__ void a_ready(const Unit&) const {}
    __device__ __forceinline__ void done(const Unit&) const {}
};

__device__ __forceinline__ unsigned cvt_pk_bf16(float lo, float hi) { unsigned r; asm volatile("v_cvt_pk_bf16_f32 %0, %1, %2" : "=v"(r) : "v"(lo), "v"(hi)); return r; }
typedef float f32x2 __attribute__((ext_vector_type(2)));
__device__ __forceinline__ f32x2 gelu_pk(f32x2 v) {
    const f32x2 av = __builtin_elementwise_abs(v), d = av * 0.2316418882f + 1.0f;
    f32x2 t; t.x = __builtin_amdgcn_rcpf(d.x); t.y = __builtin_amdgcn_rcpf(d.y);
    f32x2 q = t * 0.5307027145f + (-0.7265760135f); q = q * t + 0.7107068705f; q = q * t + (-0.142248368f); q = q * t + 0.127414796f; q = q * t;
    const f32x2 s = (v * v) * (-0.72134752044f);
    f32x2 e; e.x = __builtin_amdgcn_exp2f(s.x); e.y = __builtin_amdgcn_exp2f(s.y);
    const f32x2 m = v * (q * e), r = v - m;
    f32x2 o; o.x = v.x < 0.f ? m.x : r.x; o.y = v.y < 0.f ? m.y : r.y; return o;
}

template <int ACT  > struct EpiBf16 {
    static constexpr bool PERM = true, AFTER_DRAIN = false; static_assert(ACT == 0 || ACT == 1, "EpiBf16: ACT is 0 (none) or 1 (gelu_pk)");
    bf16_t* O; int ldc; const float* bias; int split_cols; size_t split_stride; float scale0;
    __device__ __forceinline__ void operator()(const f32x4 (&acc)[2][2][4][2], const Unit& u, int wr, int wc, int fr, int fq) const {
        const int row0 = u.pm * BM + wr * 64 + fr; int colt = u.pn * BM; bf16_t* base = O;
        float sc = 1.f; if (split_cols) { const int t = colt / split_cols; base += (size_t)t * split_stride; colt -= t * split_cols; if (t == 0) sc = scale0; }
        const int col0 = colt + wc * 32 + 8 * fq, bcol0 = u.pn * BM + wc * 32 + 8 * fq;
        f32x4 bv[2][2];
#pragma unroll
        for (int bj = 0; bj < 2; ++bj)
#pragma unroll
            for (int n = 0; n < 2; ++n) bv[bj][n] = bias ? *(const f32x4*)(bias + bcol0 + bj * HALF + 4 * n) : (f32x4){0.f, 0.f, 0.f, 0.f};
#pragma unroll
        for (int ai = 0; ai < 2; ++ai)
#pragma unroll
            for (int m = 0; m < 4; ++m) { bf16_t* rowp = base + (size_t)(row0 + ai * HALF + m * 16) * ldc + col0;
#pragma unroll
                for (int bj = 0; bj < 2; ++bj) { f32x4 v0 = acc[ai][bj][m][0] + bv[bj][0], v1 = acc[ai][bj][m][1] + bv[bj][1];
                    if (ACT == 1) { f32x2 a = gelu_pk((f32x2){v0[0], v0[1]}), b = gelu_pk((f32x2){v0[2], v0[3]}), c = gelu_pk((f32x2){v1[0], v1[1]}), d = gelu_pk((f32x2){v1[2], v1[3]});
                        v0 = (f32x4){a.x, a.y, b.x, b.y}; v1 = (f32x4){c.x, c.y, d.x, d.y}; }
                    v0 = v0 * sc; v1 = v1 * sc; u32x4 w; w.x = cvt_pk_bf16(v0[0], v0[1]); w.y = cvt_pk_bf16(v0[2], v0[3]); w.z = cvt_pk_bf16(v1[0], v1[1]); w.w = cvt_pk_bf16(v1[2], v1[3]);
                    *(u32x4*)(rowp + bj * HALF) = w; } }
    }
};
template <class Epi, class Sched, bool ALIGN_EPI = false, bool SP2 = false>
__device__ __forceinline__ void gemm_phase(PG8_LAS unsigned char* lds, const Gemm g, const Sched& S, const Epi& E) {
    int tid_ = threadIdx.x; asm volatile("" : "+v"(tid_));
    const int tid = tid_, wid = __builtin_amdgcn_readfirstlane(tid >> 6), lane = tid & 63, wr = wid >> 2, wc = wid & 3, fr = lane & 15, fq = lane >> 4;
    const int K = g.K, nt = K / BK;
    unsigned voffA[2], voffB[2];
#pragma unroll
    for (int i = 0; i < 2; ++i) { int R, C; stage_rc(tid * 16 + i * 8192, R, C); const int Rb = Epi::PERM ? ((R & ~31) + perm32(R & 31)) : R;
        voffA[i] = (unsigned)(R * K + C) * 2u; voffB[i] = (unsigned)(Rb * K + C) * 2u; }
    const size_t kstep = (size_t)(BK * 2);
    const size_t hstep = (size_t)HALF * K * 2;
    const size_t tstep = 2 * hstep;
    const unsigned ldsw = (unsigned)wid * 1024u;
    const int aoff = lds_byte(wr * 64 + fr, fq * 8), boff = lds_byte(wc * 32 + fr, fq * 8);
#define PG8_SA(b, h) (((b) * 2 + (h)) * HTB)
#define PG8_SB(b, h) ((4 + (b) * 2 + (h)) * HTB)
#define PG8_STAGE(bufoff, gbase, voff) do { _Pragma("unroll") for (int _i = 0; _i < 2; ++_i) \
        __builtin_amdgcn_global_load_lds((const unsigned*)((const char*)(gbase) + (voff)[_i]), (PG8_LAS unsigned*)(lds + (bufoff) + ldsw + _i * 8192), 16, 0, 0); } while (0)
#define PG8_LDA(dst, b, h) do { _Pragma("unroll") for (int m = 0; m < 4; ++m) _Pragma("unroll") for (int k = 0; k < 2; ++k) dst[m][k] = *(const PG8_LAS bf16x8*)(lds + PG8_SA(b, h) + aoff + m * 2048 + k * 1024); } while (0)
#define PG8_LDB(dst, b, h) do { _Pragma("unroll") for (int n = 0; n < 2; ++n) _Pragma("unroll") for (int k = 0; k < 2; ++k) dst[n][k] = *(const PG8_LAS bf16x8*)(lds + PG8_SB(b, h) + boff + n * 2048 + k * 1024); } while (0)
#define PG8_MMA(ai, bj, At, Bt) do { __builtin_amdgcn_s_setprio(1); _Pragma("unroll") for (int m = 0; m < 4; ++m) _Pragma("unroll") for (int n = 0; n < 2; ++n) _Pragma("unroll") for (int k = 0; k < 2; ++k) \
        acc[ai][bj][m][n] = __builtin_amdgcn_mfma_f32_16x16x32_bf16(Bt[n][k], At[m][k], acc[ai][bj][m][n], 0, 0, 0); __builtin_amdgcn_s_setprio(0); } while (0)
#define PG8_WAIT_V(n) asm volatile("s_waitcnt vmcnt(" #n ")" ::: "memory")
#define PG8_WAIT_L(n) asm volatile("s_waitcnt lgkmcnt(" #n ")" ::: "memory")
#define PG8_BAR __builtin_amdgcn_s_barrier()
#define PG8_SCHED __builtin_amdgcn_sched_barrier(0)
    Unit cur, nxt; int ui = 0;
    if (!S.next(0, cur)) return;
    f32x4 acc[2][2][4][2];
#pragma unroll
    for (int a = 0; a < 2; ++a)
#pragma unroll
        for (int b = 0; b < 2; ++b)
#pragma unroll
            for (int m = 0; m < 4; ++m)
#pragma unroll
                for (int n = 0; n < 2; ++n) acc[a][b][m][n] = (f32x4){0.f, 0.f, 0.f, 0.f};
    bf16x8 At[4][2], B0[2][2], B1[2][2];
    const char* cA = (const char*)g.A + (size_t)cur.pm * tstep; const char* cB = (const char*)g.Bt + (size_t)cur.pn * tstep;
    S.a_ready(cur);
    if constexpr (SP2) {
        PG8_STAGE(PG8_SB(0, 0), cB, voffB); PG8_STAGE(PG8_SB(0, 1), cB + hstep, voffB); PG8_STAGE(PG8_SA(0, 0), cA, voffA); PG8_STAGE(PG8_SA(0, 1), cA + hstep, voffA);
        if (wr == 1) PG8_BAR;
        PG8_WAIT_V(2); PG8_BAR;
        PG8_STAGE(PG8_SB(1, 0), cB + kstep, voffB); PG8_STAGE(PG8_SA(1, 0), cA + kstep, voffA); PG8_STAGE(PG8_SB(1, 1), cB + hstep + kstep, voffB);
        PG8_WAIT_V(6); PG8_BAR;
    } else {
        PG8_STAGE(PG8_SB(0, 0), cB, voffB); PG8_STAGE(PG8_SA(0, 0), cA, voffA); PG8_STAGE(PG8_SB(0, 1), cB + hstep, voffB); PG8_STAGE(PG8_SA(0, 1), cA + hstep, voffA);
        if (wr == 1) PG8_BAR;
        PG8_WAIT_V(4); PG8_BAR;
        PG8_STAGE(PG8_SB(1, 0), cB + kstep, voffB); PG8_STAGE(PG8_SA(1, 0), cA + kstep, voffA); PG8_STAGE(PG8_SB(1, 1), cB + hstep + kstep, voffB);
        PG8_WAIT_V(6); PG8_BAR;
    }
    for (;;) {
        const bool has_next = S.next(ui + 1, nxt);
        const char* nA = has_next ? (const char*)g.A + (size_t)nxt.pm * tstep : cA; const char* nB = has_next ? (const char*)g.Bt + (size_t)nxt.pn * tstep : cB;
        for (int t = 0; t < nt; t += 2) {
            const bool last = (t == nt - 2);
            const char* a1 = cA + (size_t)(t + 1) * kstep;
            const char* a2 = last ? nA : cA + (size_t)(t + 2) * kstep; const char* b2 = last ? nB : cB + (size_t)(t + 2) * kstep;
            const char* a3 = a2 + kstep; const char* b3 = b2 + kstep;
            if (last && has_next) S.a_ready(nxt);
            if constexpr (SP2) {
            PG8_LDB(B0, 0, 0); PG8_LDB(B1, 0, 1); PG8_SCHED; PG8_LDA(At, 0, 0); PG8_STAGE(PG8_SA(1, 1), a1 + hstep, voffA);
            PG8_WAIT_V(8); PG8_WAIT_L(0); PG8_BAR; PG8_MMA(0, 0, At, B0); PG8_MMA(0, 1, At, B1); PG8_BAR; PG8_SCHED;
            PG8_LDA(At, 0, 1); PG8_STAGE(PG8_SB(0, 0), b2, voffB); PG8_STAGE(PG8_SB(0, 1), b2 + hstep, voffB); PG8_STAGE(PG8_SA(0, 0), a2, voffA);
            PG8_WAIT_V(8); PG8_WAIT_L(0); PG8_BAR; PG8_MMA(1, 0, At, B0); PG8_MMA(1, 1, At, B1); PG8_BAR; PG8_SCHED;
            PG8_LDB(B0, 1, 0); PG8_LDB(B1, 1, 1); PG8_SCHED; PG8_LDA(At, 1, 0); PG8_STAGE(PG8_SA(0, 1), a2 + hstep, voffA);
            PG8_WAIT_V(8); PG8_WAIT_L(0); PG8_BAR; PG8_MMA(0, 0, At, B0); PG8_MMA(0, 1, At, B1); PG8_BAR; PG8_SCHED;
            PG8_LDA(At, 1, 1); PG8_STAGE(PG8_SB(1, 0), b3, voffB); PG8_STAGE(PG8_SB(1, 1), b3 + hstep, voffB); PG8_STAGE(PG8_SA(1, 0), a3, voffA);
            PG8_WAIT_V(8); PG8_WAIT_L(0); PG8_BAR; PG8_MMA(1, 0, At, B0); PG8_MMA(1, 1, At, B1); PG8_BAR; PG8_SCHED;
            } else {
            PG8_LDB(B0, 0, 0); PG8_SCHED; PG8_LDA(At, 0, 0); PG8_STAGE(PG8_SA(1, 1), a1 + hstep, voffA);
            PG8_WAIT_L(8); PG8_BAR; PG8_WAIT_L(0); PG8_MMA(0, 0, At, B0); PG8_BAR; PG8_SCHED;
            PG8_LDB(B1, 0, 1); PG8_STAGE(PG8_SB(0, 0), b2, voffB);
            PG8_BAR; PG8_WAIT_L(0); PG8_MMA(0, 1, At, B1); PG8_BAR;
            PG8_LDA(At, 0, 1); PG8_STAGE(PG8_SA(0, 0), a2, voffA);
            PG8_BAR; PG8_WAIT_L(0); PG8_MMA(1, 0, At, B0); PG8_BAR; PG8_SCHED;
            PG8_STAGE(PG8_SB(0, 1), b2 + hstep, voffB);
            PG8_WAIT_V(6); PG8_BAR; PG8_MMA(1, 1, At, B1); PG8_BAR;
            PG8_LDB(B0, 1, 0); PG8_SCHED; PG8_LDA(At, 1, 0); PG8_STAGE(PG8_SA(0, 1), a2 + hstep, voffA);
            PG8_WAIT_L(8); PG8_BAR; PG8_WAIT_L(0); PG8_MMA(0, 0, At, B0); PG8_BAR; PG8_SCHED;
            PG8_LDB(B1, 1, 1); PG8_STAGE(PG8_SB(1, 0), b3, voffB);
            PG8_BAR; PG8_WAIT_L(0); PG8_MMA(0, 1, At, B1); PG8_BAR;
            PG8_LDA(At, 1, 1); PG8_STAGE(PG8_SA(1, 0), a3, voffA);
            PG8_BAR; PG8_WAIT_L(0); PG8_MMA(1, 0, At, B0); PG8_BAR; PG8_SCHED;
            PG8_STAGE(PG8_SB(1, 1), b3 + hstep, voffB);
            PG8_WAIT_V(6); PG8_BAR; PG8_MMA(1, 1, At, B1); PG8_BAR;
            }
        }
        if constexpr (ALIGN_EPI) { if (wr == 0) PG8_BAR; }
        if constexpr (!Epi::AFTER_DRAIN) { E(acc, cur, wr, wc, fr, fq); S.done(cur); }
        if (!has_next) break;
#pragma unroll
        for (int a = 0; a < 2; ++a)
#pragma unroll
            for (int b = 0; b < 2; ++b)
#pragma unroll
                for (int m = 0; m < 4; ++m)
#pragma unroll
                    for (int n = 0; n < 2; ++n) acc[a][b][m][n] = (f32x4){0.f, 0.f, 0.f, 0.f};
        cur = nxt; cA = nA; cB = nB; ++ui;
        if constexpr (ALIGN_EPI) { if (wr == 1) PG8_BAR; }
    }
    PG8_WAIT_V(0);
    if constexpr (!ALIGN_EPI) { if (wr == 0) PG8_BAR; }
    PG8_BAR;
    if constexpr (Epi::AFTER_DRAIN) { E.fused(acc, cur, wr, wc, fr, fq, lds, wid, lane); S.done(cur); }
#undef PG8_SA
#undef PG8_SB
#undef PG8_STAGE
#undef PG8_LDA
#undef PG8_LDB
#undef PG8_MMA
#undef PG8_WAIT_V
#undef PG8_WAIT_L
#undef PG8_BAR
#undef PG8_SCHED
}
}
#include <hip/hip_bf16.h>
#include <cmath>
namespace attn_body {
using bf16=__hip_bfloat16;
using bf16x8=__attribute__((ext_vector_type(8)))short;
using s16x4=__attribute__((ext_vector_type(4)))short;
using f32x16=__attribute__((ext_vector_type(16)))float;
using u32x4=__attribute__((ext_vector_type(4)))unsigned;
constexpr int D=64,QP=512,KP=128,OP=1024;
constexpr int NW=8,QBLK=32,QB=QBLK*NW,KVBLK=64;
constexpr int ATTN_UNIT_ROWS=QB;
__device__ __forceinline__ int crow(int r,int hi){return (r&3)+8*(r>>2)+4*hi;}
#define SBAR() __builtin_amdgcn_sched_barrier(0)
__device__ __forceinline__ void cmask(f32x16&p0,f32x16&p1,int jb,int qrel,int hi){
  const float NEG=-INFINITY; int kb=64*jb+4*hi;
  #pragma unroll
  for(int r=0;r<16;++r){int kv=kb+(r&3)+8*(r>>2); if(kv>qrel)p0[r]=NEG; if(kv+32>qrel)p1[r]=NEG;}
}

constexpr int NSLOT=3, SLOTB=8192;
constexpr int NVSLOT=4;
constexpr int LDS_K=0, LDS_V=NSLOT*SLOTB, LDS_WS=(NSLOT+NVSLOT)*SLOTB, LDS_OST=LDS_WS+NW*64*4, LDS_BYTES=LDS_OST+NW*4096;
constexpr float C2=0.125f*1.4426950408889634f;
__device__ __forceinline__ void glds16(const void*gsrc,unsigned lds_dst){unsigned keep;
  asm volatile("s_mov_b32 %0, m0\n\ts_mov_b32 m0, %2\n\ts_nop 0\n\tglobal_load_lds_dwordx4 %1, off\n\ts_mov_b32 m0, %0":"=&s"(keep):"v"(gsrc),"s"(lds_dst):"memory");}
__device__ __forceinline__ float max3f(float a,float b,float c){float r;asm("v_max3_f32 %0, %1, %2, %3":"=v"(r):"v"(a),"v"(b),"v"(c));return r;}
__device__ __forceinline__ float max2f(float a,float b){float r;asm("v_max_f32_e32 %0, %1, %2":"=v"(r):"v"(a),"v"(b));return r;}
__device__ __forceinline__ float fadd_s(float a,float b){float r;asm("v_add_f32_e32 %0, %1, %2":"=v"(r):"v"(a),"v"(b));return r;}
__device__ __forceinline__ float fsub_s(float a,float b){float r;asm("v_sub_f32_e32 %0, %1, %2":"=v"(r):"v"(a),"v"(b));return r;}
typedef float f32x2_t __attribute__((ext_vector_type(2))); typedef __bf16 bf16x2_t __attribute__((ext_vector_type(2)));
__device__ __forceinline__ unsigned cvtpk_s(float lo,float hi){f32x2_t v={lo,hi};bf16x2_t b=__builtin_convertvector(v,bf16x2_t);return __builtin_bit_cast(unsigned,b);}
#define WAIT_BAR(N) asm volatile("s_waitcnt vmcnt(" #N ") lgkmcnt(0)\n\ts_barrier":::"memory")

__device__ __forceinline__ void qkt(f32x16&p0,f32x16&p1,const char*Kslot,const bf16x8*qr,const f32x16&negm,int r32,int hi){
  const char*kb=Kslot+hi*1024+r32*16;
  #pragma unroll
  for(int d0=0;d0<4;++d0){
    const bf16x8 b0=*reinterpret_cast<const bf16x8*>(kb+d0*2048);
    const bf16x8 b1=*reinterpret_cast<const bf16x8*>(kb+d0*2048+512);
    if(d0==0){p0=__builtin_amdgcn_mfma_f32_32x32x16_bf16(b0,qr[0],negm,0,0,0);p1=__builtin_amdgcn_mfma_f32_32x32x16_bf16(b1,qr[0],negm,0,0,0);}
    else{p0=__builtin_amdgcn_mfma_f32_32x32x16_bf16(b0,qr[d0],p0,0,0,0);p1=__builtin_amdgcn_mfma_f32_32x32x16_bf16(b1,qr[d0],p1,0,0,0);}}
}
typedef __attribute__((address_space(3))) const char* lds_cptr;
typedef short v4i16_t __attribute__((ext_vector_type(4)));
__device__ __forceinline__ void kload8(bf16x8*kf,lds_cptr kp){
  kf[0]=*(const __attribute__((address_space(3))) bf16x8*)(kp);      kf[1]=*(const __attribute__((address_space(3))) bf16x8*)(kp+512);
  kf[2]=*(const __attribute__((address_space(3))) bf16x8*)(kp+2048); kf[3]=*(const __attribute__((address_space(3))) bf16x8*)(kp+2560);
  kf[4]=*(const __attribute__((address_space(3))) bf16x8*)(kp+4096); kf[5]=*(const __attribute__((address_space(3))) bf16x8*)(kp+4608);
  kf[6]=*(const __attribute__((address_space(3))) bf16x8*)(kp+6144); kf[7]=*(const __attribute__((address_space(3))) bf16x8*)(kp+6656);
}
__device__ __forceinline__ void kload2(bf16x8*kf,lds_cptr kp,int j){ kf[2*j]=*(const __attribute__((address_space(3))) bf16x8*)(kp+j*2048); kf[2*j+1]=*(const __attribute__((address_space(3))) bf16x8*)(kp+j*2048+512); }
__device__ __forceinline__ s16x4 vtr(lds_cptr p){ return __builtin_bit_cast(s16x4,__builtin_amdgcn_ds_read_tr16_b64_v4i16((__attribute__((address_space(3))) v4i16_t*)p)); }
__device__ __forceinline__ float rowmax(const f32x16&p0,const f32x16&p1){
  float a=max3f(p0[0],p0[1],p1[0]),b=max3f(p0[2],p0[3],p1[1]);a=max3f(a,p1[2],p1[3]);
  #pragma unroll
  for(int r=4;r<16;r+=4){a=max3f(a,p0[r],p0[r+1]);b=max3f(b,p0[r+2],p0[r+3]);a=max3f(a,p1[r],p1[r+1]);b=max3f(b,p1[r+2],p1[r+3]);}
  const float m=max2f(a,b);
  auto rr=__builtin_amdgcn_permlane32_swap(__float_as_uint(m),__float_as_uint(m),false,false);
  return max2f(__uint_as_float(rr[0]),__uint_as_float(rr[1]));
}
__device__ __forceinline__ void pv(f32x16*o,int vb,bf16x8 pa0,bf16x8 pa1,bf16x8 pa2,bf16x8 pa3){
  #pragma unroll
  for(int d0=0;d0<2;++d0){s16x4 lo[4],hi[4];
    #pragma unroll
    for(int ks=0;ks<4;++ks){
      asm volatile("ds_read_b64_tr_b16 %0,%1 offset:%c2":"=&v"(lo[ks]):"v"(vb),"i"(d0*4096+ks*1024):"memory");
      asm volatile("ds_read_b64_tr_b16 %0,%1 offset:%c2":"=&v"(hi[ks]):"v"(vb),"i"(d0*4096+ks*1024+512):"memory");}
    asm volatile("s_waitcnt lgkmcnt(0)":::"memory");SBAR();
    #define PK(k) (bf16x8){lo[k][0],lo[k][1],lo[k][2],lo[k][3],hi[k][0],hi[k][1],hi[k][2],hi[k][3]}
    o[d0]=__builtin_amdgcn_mfma_f32_32x32x16_bf16(pa0,PK(0),o[d0],0,0,0);
    o[d0]=__builtin_amdgcn_mfma_f32_32x32x16_bf16(pa1,PK(1),o[d0],0,0,0);
    o[d0]=__builtin_amdgcn_mfma_f32_32x32x16_bf16(pa2,PK(2),o[d0],0,0,0);
    o[d0]=__builtin_amdgcn_mfma_f32_32x32x16_bf16(pa3,PK(3),o[d0],0,0,0);
    #undef PK
  }
}

#ifndef ATTN_STORE16
#define ATTN_STORE16(p,v) (*(u32x4*)(p)=(v))
#endif
template<int THRL> __device__ __forceinline__ void attn_unit(const bf16*Q0,const bf16*__restrict__ Kh,const bf16*__restrict__ Vh,bf16*O0,const int NT,char*shm,const int split,float*part,const float*partner,unsigned*cnt,const int ncomp){
  int tid_=threadIdx.x; asm volatile("":"+v"(tid_));
  const int tid=tid_,lane=tid&63,r32=lane&31,hi=lane>>5; const int wid=__builtin_amdgcn_readfirstlane(tid>>6);
  const bf16*Qw=Q0+(long)(wid*QBLK)*QP;
  const unsigned lds0=(unsigned)(uintptr_t)shm;
  float*wsf=(float*)(shm+LDS_WS)+wid*64;
  const bf16*ksrc=Kh+(long)lane*KP+wid*8;
  const bf16*vsrc=Vh+(long)(16*(wid&3)+(lane>>2))*KP+(wid>>2)*32+(lane&3)*8;
  const unsigned kdst=lds0+LDS_K+wid*1024, vdst=lds0+LDS_V+wid*1024;
  #define DMA_K(t,slot) glds16(ksrc+(long)(t)*KVBLK*KP,(unsigned)__builtin_amdgcn_readfirstlane(kdst+(slot)))
  #define DMA_V(t,slot) glds16(vsrc+(long)(t)*KVBLK*KP,(unsigned)__builtin_amdgcn_readfirstlane(vdst+(slot)))
  const int vb0=(int)(lds0+LDS_V)+((lane>>4)&1)*32+(lane&3)*8+(4*hi+((lane&15)>>2))*64;
  const char*Kbase=shm+LDS_K; bf16x8 kf[8];
  const lds_cptr shm3=(lds_cptr)shm; const lds_cptr kp0=shm3+LDS_K+hi*1024+r32*16; const lds_cptr vp0=shm3+LDS_V+((lane>>4)&1)*32+(lane&3)*8+(4*hi+((lane&15)>>2))*64;
  const bool stream=(ncomp==4);
  if(stream&&wid>=4){
    const int p0=2*(wid-4);
    const bf16*ks0=Kh+(long)lane*KP+p0*8, *ks1=ks0+8;
    const bf16*vs0=Vh+(long)(16*(p0&3)+(lane>>2))*KP+(p0>>2)*32+(lane&3)*8, *vs1=Vh+(long)(16*((p0+1)&3)+(lane>>2))*KP+((p0+1)>>2)*32+(lane&3)*8;
    const unsigned kd0=lds0+LDS_K+p0*1024, vd0=lds0+LDS_V+p0*1024;
    #define SK_(t) do{ const unsigned so_=(unsigned)(((t)%3)*SLOTB); glds16(ks0+(long)(t)*KVBLK*KP,(unsigned)__builtin_amdgcn_readfirstlane(kd0+so_)); glds16(ks1+(long)(t)*KVBLK*KP,(unsigned)__builtin_amdgcn_readfirstlane(kd0+1024+so_)); }while(0)
    #define SV_(t) do{ const unsigned so_=(unsigned)(((t)&3)*SLOTB); glds16(vs0+(long)(t)*KVBLK*KP,(unsigned)__builtin_amdgcn_readfirstlane(vd0+so_)); glds16(vs1+(long)(t)*KVBLK*KP,(unsigned)__builtin_amdgcn_readfirstlane(vd0+1024+so_)); }while(0)
    SK_(0);SV_(0);SK_(1);SV_(1);SK_(2);
    WAIT_BAR(8);
    WAIT_BAR(0);
    SV_(2);SK_(3);
    WAIT_BAR(4);
    for(int t=1;t+1<NT;++t){
      const bool gv=(t+2<NT),gk=(t+3<NT);
      if(gv){SV_(t+2);} if(gk){SK_(t+3);}
      if(gk){WAIT_BAR(4);} else if(gv){WAIT_BAR(2);} else {WAIT_BAR(0);}
    }
    asm volatile("s_waitcnt lgkmcnt(0)\n\ts_barrier":::"memory");
    #undef SK_
    #undef SV_
    return;
  }
  const bool dma_en=!stream;
  const int vwrap=(stream?NVSLOT-1:NSLOT-1)*SLOTB;
  if(dma_en){
  DMA_K(0,0);DMA_V(0,0);DMA_K(1,SLOTB);
  }
  bf16x8 qr[4];
  #pragma unroll
  for(int d0=0;d0<4;++d0)qr[d0]=*reinterpret_cast<const bf16x8*>(&Qw[(long)r32*QP+d0*16+hi*8]);
  float mhat=0.f,l_reg=0.f;f32x16 o[2];o[0]=f32x16{};o[1]=f32x16{};f32x16 negm=f32x16{};asm volatile("":"+v"(negm));
  #define CMASK(P0,P1,t) do{}while(0)
  bool resc=false;
  #define START(P0,P1) do{ const float rm=rowmax(P0,P1); resc=false; \
    { const float dl=rm; mhat=fadd_s(mhat,dl); \
      _Pragma("unroll") for(int r=0;r<16;++r){P0[r]=fsub_s(P0[r],dl);P1[r]=fsub_s(P1[r],dl);} \
      _Pragma("unroll") for(int r=0;r<16;++r)negm[r]=-mhat; asm volatile("":"+v"(negm)); } \
    _Pragma("unroll") for(int r=0;r<16;++r)P0[r]=__builtin_amdgcn_exp2f(P0[r]); }while(0)
  #define RESC() do{ if(resc){ asm volatile("s_waitcnt lgkmcnt(0)":::"memory"); \
      _Pragma("unroll") for(int d_=0;d_<2;++d_) _Pragma("unroll") for(int r=0;r<16;++r)o[d_][r]*=wsf[crow(r,hi)]; } }while(0)
  f32x16 pA0,pA1,pB0,pB1;
  int sl_prev=0,sl_cur=0,sl_next=SLOTB;
  int vs_prev=0,vs_cur=0,vs_next=SLOTB;
  #define ROT() do{sl_prev=sl_cur;sl_cur=sl_next;sl_next=(sl_next==(NSLOT-1)*SLOTB)?0:sl_next+SLOTB; vs_prev=vs_cur;vs_cur=vs_next;vs_next=(vs_next==vwrap)?0:vs_next+SLOTB;}while(0)
  if(dma_en){DMA_K(2,2*SLOTB);}
  WAIT_BAR(3);
  qkt(pA0,pA1,Kbase,qr,negm,r32,hi);asm volatile("s_nop 15\n\ts_nop 7":"+v"(pA0),"+v"(pA1));CMASK(pA0,pA1,0);
  START(pA0,pA1);
  _Pragma("unroll") for(int r=0;r<16;++r)pA1[r]=__builtin_amdgcn_exp2f(pA1[r]);
  WAIT_BAR(0);
  if(dma_en){DMA_K(3,0);DMA_V(1,SLOTB);}
  ROT();
  kload8(kf,kp0+sl_cur);
  WAIT_BAR(2);
  s16x4 vlo[8],vhi[8]; u32x4 pw0,pw1,pw2,pw3;
  #define PKW(P,B) cvtpk_s(P[B],P[B+1])
  #define PAF(k) __builtin_bit_cast(bf16x8,pw##k)
  #define VFR(i) (bf16x8){vlo[i][0],vlo[i][1],vlo[i][2],vlo[i][3],vhi[i][0],vhi[i][1],vhi[i][2],vhi[i][3]}
  #define PIN(x) asm volatile("":"+v"(x))
  #define MX3(a,b,c) __builtin_fmaxf(__builtin_fmaxf((a),(b)),(c))
  #define GAPA(MF,A0,A1,A2,A3,W0,W1,PW) do{ MF; sacc+=A0; sacc+=A1; sacc+=A2; sacc+=A3; PIN(sacc); W0; W1; PIN(PW); SBAR(); }while(0)
  #define EX(v) __builtin_amdgcn_exp2f(v)
  #define GAPB(MF,X,B) do{ MF; X[B]=EX(X[B]); X[B+1]=EX(X[B+1]); X[B+2]=EX(X[B+2]); X[B+3]=EX(X[B+3]); PIN(X); SBAR(); }while(0)
  #define VRD(i) do{ vlo[i]=vtr(vp_+(((i)>>2)*4096+((i)&3)*1024)); vhi[i]=vtr(vp_+(((i)>>2)*4096+((i)&3)*1024+512)); }while(0)
  #define KRD(G,j) do{ if(G){ kload2(kf,kp0+sl_next,j); SBAR(); } }while(0)
  #define STEP(C0,C1,P0,P1,t,GK,GV,GL) do{ SBAR(); \
    const lds_cptr vp_=vp0+vs_prev; \
    VRD(0); SBAR(); float sacc=(P0[0]+P0[1]); \
    GAPA(C0=__builtin_amdgcn_mfma_f32_32x32x16_bf16(kf[0],qr[0],negm,0,0,0), P0[2],P0[3],P0[4],P0[5],     pw0[0]=PKW(P0,0), pw0[1]=PKW(P0,2), pw0); \
    VRD(4); SBAR(); GAPA(C1=__builtin_amdgcn_mfma_f32_32x32x16_bf16(kf[1],qr[0],negm,0,0,0), P0[6],P0[7],P0[8],P0[9],     pw0[2]=PKW(P0,4), pw0[3]=PKW(P0,6), pw0); \
    VRD(1); SBAR(); GAPA(C0=__builtin_amdgcn_mfma_f32_32x32x16_bf16(kf[2],qr[1],C0,0,0,0),   P0[10],P0[11],P0[12],P0[13], pw1[0]=PKW(P0,8), pw1[1]=PKW(P0,10), pw1); \
    VRD(5); SBAR(); GAPA(C1=__builtin_amdgcn_mfma_f32_32x32x16_bf16(kf[3],qr[1],C1,0,0,0),   P0[14],P0[15],P1[0],P1[1],   pw1[2]=PKW(P0,12),pw1[3]=PKW(P0,14), pw1); \
    VRD(2); SBAR(); GAPA(C0=__builtin_amdgcn_mfma_f32_32x32x16_bf16(kf[4],qr[2],C0,0,0,0),   P1[2],P1[3],P1[4],P1[5],     pw2[0]=PKW(P1,0), pw2[1]=PKW(P1,2), pw2); \
    VRD(6); SBAR(); GAPA(C1=__builtin_amdgcn_mfma_f32_32x32x16_bf16(kf[5],qr[2],C1,0,0,0),   P1[6],P1[7],P1[8],P1[9],     pw2[2]=PKW(P1,4), pw2[3]=PKW(P1,6), pw2); \
    VRD(3); SBAR(); GAPA(C0=__builtin_amdgcn_mfma_f32_32x32x16_bf16(kf[6],qr[3],C0,0,0,0),   P1[10],P1[11],P1[12],P1[13], pw3[0]=PKW(P1,8), pw3[1]=PKW(P1,10), pw3); \
    VRD(7); SBAR(); GAPA(C1=__builtin_amdgcn_mfma_f32_32x32x16_bf16(kf[7],qr[3],C1,0,0,0),   P1[14],P1[15],0.f,0.f,       pw3[2]=PKW(P1,12),pw3[3]=PKW(P1,14), pw3); \
    l_reg+=sacc; \
    if(dma_en){ if(GK){DMA_K((t)+3,sl_cur);} if(GV){DMA_V((t)+1,sl_next);} } \
    CMASK(C0,C1,t); \
    { float a=MX3(C0[0],C0[1],C1[0]),b=MX3(C0[2],C0[3],C1[1]); a=MX3(a,C1[2],C1[3]); \
      _Pragma("unroll") for(int r=4;r<16;r+=4){a=MX3(a,C0[r],C0[r+1]);b=MX3(b,C0[r+2],C0[r+3]);a=MX3(a,C1[r],C1[r+1]);b=MX3(b,C1[r+2],C1[r+3]);} \
      float rm=__builtin_fmaxf(a,b); { auto rr=__builtin_amdgcn_permlane32_swap(__float_as_uint(rm),__float_as_uint(rm),false,false); rm=__builtin_fmaxf(__uint_as_float(rr[0]),__uint_as_float(rr[1])); } \
      resc=false; \
      if(__builtin_expect(__any(rm>(float)THRL),0)){ const float dl=__builtin_fmaxf(rm,0.f); mhat+=dl; \
        _Pragma("unroll") for(int r=0;r<16;++r){C0[r]-=dl;C1[r]-=dl;} \
        _Pragma("unroll") for(int r=0;r<16;++r)negm[r]=-mhat; asm volatile("":"+v"(negm)); \
        const float f=__builtin_amdgcn_exp2f(-dl); l_reg*=f; if(hi==0)wsf[r32]=f; resc=true; } } \
    SBAR(); \
    GAPB(o[0]=__builtin_amdgcn_mfma_f32_32x32x16_bf16(PAF(0),VFR(0),o[0],0,0,0), C0,0); \
    GAPB(o[1]=__builtin_amdgcn_mfma_f32_32x32x16_bf16(PAF(0),VFR(4),o[1],0,0,0), C0,4); \
    KRD(GL,0); GAPB(o[0]=__builtin_amdgcn_mfma_f32_32x32x16_bf16(PAF(1),VFR(1),o[0],0,0,0), C0,8); \
    KRD(GL,1); GAPB(o[1]=__builtin_amdgcn_mfma_f32_32x32x16_bf16(PAF(1),VFR(5),o[1],0,0,0), C0,12); \
    KRD(GL,2); GAPB(o[0]=__builtin_amdgcn_mfma_f32_32x32x16_bf16(PAF(2),VFR(2),o[0],0,0,0), C1,0); \
    KRD(GL,3); GAPB(o[1]=__builtin_amdgcn_mfma_f32_32x32x16_bf16(PAF(2),VFR(6),o[1],0,0,0), C1,4); \
    GAPB(o[0]=__builtin_amdgcn_mfma_f32_32x32x16_bf16(PAF(3),VFR(3),o[0],0,0,0), C1,8); \
    GAPB(o[1]=__builtin_amdgcn_mfma_f32_32x32x16_bf16(PAF(3),VFR(7),o[1],0,0,0), C1,12); \
    }while(0)
  int t=1;
  #undef CMASK
  #define CMASK(P0,P1,t) do{}while(0)
  for(;t+5<NT;t+=2){
    STEP(pB0,pB1,pA0,pA1,t,true,true,true);     WAIT_BAR(2); RESC(); ROT();
    STEP(pA0,pA1,pB0,pB1,t+1,true,true,true);   WAIT_BAR(2); RESC(); ROT();
  }
  #undef CMASK
  #define CMASK(P0,P1,t) do{}while(0)
  #define ENDW(tt) do{ if((tt)+3<NT){WAIT_BAR(2);} else if((tt)+2<NT){WAIT_BAR(1);} else {WAIT_BAR(0);} }while(0)
  for(;t+1<NT;t+=2){
    STEP(pB0,pB1,pA0,pA1,t,(t+3<NT),(t+1<NT),(t+1<NT));       ENDW(t);   RESC(); ROT();
    STEP(pA0,pA1,pB0,pB1,t+1,(t+4<NT),(t+2<NT),(t+2<NT));     ENDW(t+1); RESC(); ROT();
  }
  STEP(pB0,pB1,pA0,pA1,NT-1,false,false,false); RESC();
  { float sacc=pB0[0]+pB0[1]; _Pragma("unroll") for(int r=2;r<16;++r)sacc+=pB0[r]; _Pragma("unroll") for(int r=0;r<16;++r)sacc+=pB1[r]; l_reg+=sacc;
    pw0=(u32x4){PKW(pB0,0),PKW(pB0,2),PKW(pB0,4),PKW(pB0,6)};pw1=(u32x4){PKW(pB0,8),PKW(pB0,10),PKW(pB0,12),PKW(pB0,14)};pw2=(u32x4){PKW(pB1,0),PKW(pB1,2),PKW(pB1,4),PKW(pB1,6)};pw3=(u32x4){PKW(pB1,8),PKW(pB1,10),PKW(pB1,12),PKW(pB1,14)};
    SBAR(); pv(o,vb0+vs_cur,PAF(0),PAF(1),PAF(2),PAF(3)); }
  #undef PKW
  #undef PAF
  #undef VFR
  #undef PIN
  #undef MX3
  #undef GAPA
  #undef GAPB
  #undef EX
  #undef VRD
  #undef KRD
  #undef STEP
  #undef ENDW
  {auto rr=__builtin_amdgcn_permlane32_swap(__float_as_uint(l_reg),__float_as_uint(l_reg),false,false);l_reg=__uint_as_float(rr[0])+__uint_as_float(rr[1]);}
  if(hi==0)wsf[32+r32]=l_reg;asm volatile("s_waitcnt lgkmcnt(0)":::"memory");
  float rli[16];
  bool writer=true;
  if(split){
    float*po=part+wid*2048; float*ps=part+8*2048+wid*64;
    #pragma unroll
    for(int d0=0;d0<2;++d0)
      #pragma unroll
      for(int r=0;r<16;++r)__hip_atomic_store(po+(d0*16+r)*64+lane,o[d0][r],__ATOMIC_RELAXED,__HIP_MEMORY_SCOPE_AGENT);
    if(hi==0){__hip_atomic_store(ps+r32,mhat,__ATOMIC_RELAXED,__HIP_MEMORY_SCOPE_AGENT);__hip_atomic_store(ps+32+r32,l_reg,__ATOMIC_RELAXED,__HIP_MEMORY_SCOPE_AGENT);}
    asm volatile("s_waitcnt vmcnt(0)":::"memory");
    unsigned old_=0u; if(lane==0)old_=__hip_atomic_fetch_add(cnt+wid,1u,__ATOMIC_RELAXED,__HIP_MEMORY_SCOPE_AGENT);
    old_=(unsigned)__builtin_amdgcn_readfirstlane((int)old_);
    writer=(old_!=0u);
    if(writer){
      __builtin_amdgcn_fence(__ATOMIC_ACQUIRE,"agent");
      const float*qo=partner+wid*2048; const float*qs=partner+8*2048+wid*64;
      const float mp=__hip_atomic_load(qs+r32,__ATOMIC_RELAXED,__HIP_MEMORY_SCOPE_AGENT),lp=__hip_atomic_load(qs+32+r32,__ATOMIC_RELAXED,__HIP_MEMORY_SCOPE_AGENT);
      const float Mx=__builtin_fmaxf(mhat,mp),fo=__builtin_amdgcn_exp2f(mhat-Mx),fp=__builtin_amdgcn_exp2f(mp-Mx);
      const float inv=__builtin_amdgcn_rcpf(l_reg*fo+lp*fp);
      if(hi==0){wsf[32+r32]=fo*inv;wsf[r32]=fp*inv;} asm volatile("s_waitcnt lgkmcnt(0)":::"memory");
      #pragma unroll
      for(int r=0;r<16;++r){const float so=wsf[32+crow(r,hi)],sp=wsf[crow(r,hi)];
        #pragma unroll
        for(int d0=0;d0<2;++d0)o[d0][r]=o[d0][r]*so+__hip_atomic_load(qo+(d0*16+r)*64+lane,__ATOMIC_RELAXED,__HIP_MEMORY_SCOPE_AGENT)*sp;
        rli[r]=1.f;}
    }
  } else {
  #pragma unroll
  for(int r=0;r<16;++r)rli[r]=__builtin_amdgcn_rcpf(wsf[32+crow(r,hi)]);
  }
  bf16*Ow=O0+(long)(wid*QBLK)*OP;
  if(writer){ bf16*stg=(bf16*)(shm+LDS_OST)+wid*2048;
    #pragma unroll
    for(int r=0;r<16;++r){const int orow=crow(r,hi);
      #pragma unroll
      for(int d0=0;d0<2;++d0)stg[orow*64+d0*32+r32]=__float2bfloat16(o[d0][r]*rli[r]);}
    asm volatile("s_waitcnt lgkmcnt(0)":::"memory");
    #pragma unroll
    for(int i=0;i<4;++i){const int row=i*8+(lane>>3),ch=lane&7; const u32x4 v=*(const u32x4*)(stg+row*64+ch*8); ATTN_STORE16(Ow+(long)row*OP+ch*8,v);} }
  asm volatile("s_waitcnt lgkmcnt(0)\n\ts_barrier":::"memory");
  #undef DMA_K
  #undef DMA_V
  #undef CMASK
  #undef START
  #undef RESC
  #undef ROT
}
constexpr int ATTN_LDS_BYTES=LDS_BYTES;
#undef SBAR
#undef WAIT_BAR
}
#define GAS __attribute__((address_space(1)))
#define LAS __attribute__((address_space(3)))
typedef unsigned short bf16;
typedef unsigned v4u __attribute__((ext_vector_type(4)));
typedef unsigned v2u __attribute__((ext_vector_type(2)));
typedef float f32x4 __attribute__((ext_vector_type(4)));
#define LDS_WAIT() asm volatile("s_waitcnt lgkmcnt(0)" ::: "memory")
__device__ __forceinline__ unsigned f2bf(float f) { unsigned u = __builtin_bit_cast(unsigned, f); return (u + 0x7fffu + ((u >> 16) & 1u)) >> 16; }
__device__ __forceinline__ unsigned pk2(float lo, float hi) { return pg8::cvt_pk_bf16(lo, hi); }
__device__ __forceinline__ float bf_lo(unsigned w) { return __builtin_bit_cast(float, w << 16); }
__device__ __forceinline__ float bf_hi(unsigned w) { return __builtin_bit_cast(float, w & 0xffff0000u); }
typedef _Float16 h16x2 __attribute__((ext_vector_type(2)));
__device__ __forceinline__ unsigned pkh2(float lo, float hi) { h16x2 v = {(_Float16)lo, (_Float16)hi}; return __builtin_bit_cast(unsigned, v); }
__device__ __forceinline__ float h_lo(unsigned w) { return (float)__builtin_bit_cast(h16x2, w).x; }
__device__ __forceinline__ float h_hi(unsigned w) { return (float)__builtin_bit_cast(h16x2, w).y; }

constexpr int D = 1024, NCTX = 8192, NLAT = 4096, M = NCTX + NLAT, DEPTH = 4, SEQ = 256, LSEQ = 2048, PAST = 512, LKEYS = PAST + LSEQ;
constexpr int NIN = 1280, DFF = 2816, NUP = 2 * DFF, NMOD = 6 * D;
constexpr float EPS = 1e-6f;
constexpr int NWAVES = 8, NTHR = 512;
constexpr size_t MiB = 1u << 20;
constexpr size_t WS_ZERO_BYTES = 2 * MiB;
constexpr size_t WS_MOD = 1 * MiB;
constexpr size_t WS_ACNT = 64 * 1024;
constexpr int APART_FLOATS = 8 * 2048 + 8 * 64;
constexpr size_t WS_APART = 222 * MiB;
constexpr size_t WS_RS = 262 * MiB;
constexpr size_t WS_GM = 12 * MiB + 512 * 1024;
constexpr size_t WS_B1 = 12 * MiB + 768 * 1024;
constexpr size_t WS_B5 = 13 * MiB;
constexpr size_t WS_WIN = 2 * MiB;
constexpr size_t WS_WOUT = 14 * MiB;
constexpr size_t WS_WUP = 22 * MiB;
constexpr size_t WS_WDN = 66 * MiB;
constexpr size_t WS_X = 88 * MiB;
constexpr size_t WS_H = 354 * MiB;
constexpr size_t WS_Q = 160 * MiB;
constexpr size_t WS_U = 172 * MiB;
constexpr size_t WS_AO = 184 * MiB;
constexpr size_t WS_ACT = 136 * MiB;
constexpr size_t WS_KC = 208 * MiB, WS_VC = 210 * MiB;
constexpr size_t WS_KL = 212 * MiB, WS_VL = 217 * MiB;
constexpr size_t WS_HALO = 222 * MiB + 32 * MiB;
constexpr size_t WS_Z = 222 * MiB;
constexpr size_t WS_END = 378 * MiB;
static_assert(WS_ACT + (size_t)M * DFF * 2 <= WS_KC, "ACT overlay");
constexpr int LDS_BYTES = 147456;

struct Args { const float* in[21]; float* out; unsigned char* ws; int ph_lo, ph_hi; };
enum { I_XP = 0, I_XS, I_CK, I_CV, I_C, I_CCTX, I_WMOD, I_BMOD, I_N1G, I_WIN, I_QG, I_KG, I_WPOOL, I_PSC, I_WOUT, I_N2G, I_WUP, I_CW, I_CB, I_WDN, I_FNG };

__device__ __forceinline__ float xadd16(float v) { auto r = __builtin_amdgcn_permlane16_swap(__float_as_uint(v), __float_as_uint(v), false, false); return __uint_as_float(r[0]) + __uint_as_float(r[1]); }
__device__ __forceinline__ float xadd32(float v) { auto r = __builtin_amdgcn_permlane32_swap(__float_as_uint(v), __float_as_uint(v), false, false); return __uint_as_float(r[0]) + __uint_as_float(r[1]); }
template <int CTRL> __device__ __forceinline__ float dpp_f(float v) { return __int_as_float(__builtin_amdgcn_update_dpp(0, __float_as_int(v), CTRL, 0xf, 0xf, false)); }
__device__ __forceinline__ float wave_sum(float v) {
    v += dpp_f<0xB1>(v);
    v += dpp_f<0x4E>(v);
    v += dpp_f<0x124>(v);
    v += dpp_f<0x128>(v);
    return xadd32(xadd16(v));
}
__device__ __forceinline__ const float* ain(const Args& a, int i) { asm volatile("" : "+s"(i)); return a.in[i]; }
__device__ __forceinline__ int row_cond(int row) { return row < NCTX ? 0 : 1 + ((row - NCTX) >> 11); }

struct TrItem { const float* src; bf16* dst; int ldw, ldt; };
__device__ __forceinline__ void tr_load(const TrItem& t, float (&r)[32], int lane) {
#pragma unroll
    for (int i = 0; i < 8; ++i) { const f32x4 v = *(const f32x4*)(t.src + (size_t)(8 * i + (lane >> 3)) * t.ldw + (lane & 7) * 4);
        r[4 * i] = v.x; r[4 * i + 1] = v.y; r[4 * i + 2] = v.z; r[4 * i + 3] = v.w; }
}
__device__ __forceinline__ void tr_store(const TrItem& t, const float (&r)[32], LAS float* scr, int lane) {
#pragma unroll
    for (int i = 0; i < 8; ++i) { LAS float* p = scr + (8 * i + (lane >> 3)) * 33 + (lane & 7) * 4;
        p[0] = r[4 * i]; p[1] = r[4 * i + 1]; p[2] = r[4 * i + 2]; p[3] = r[4 * i + 3]; }
    LDS_WAIT(); asm volatile("" ::: "memory");
    const int c = lane & 7;
#pragma unroll
    for (int j = 0; j < 4; ++j) { const int n = (lane >> 3) + 8 * j; const LAS float* s = scr + (8 * c) * 33 + n;
        v4u o; o.x = pk2(s[0 * 33], s[1 * 33]); o.y = pk2(s[2 * 33], s[3 * 33]); o.z = pk2(s[4 * 33], s[5 * 33]); o.w = pk2(s[6 * 33], s[7 * 33]);
        *(v4u*)(t.dst + (size_t)n * t.ldt + 8 * c) = o; }
    LDS_WAIT(); asm volatile("" ::: "memory");
}
__device__ __forceinline__ float silu_f(float x) { return x / (1.f + __expf(-x)); }

__device__ __forceinline__ void weff_layer(const Args& a, unsigned char* ws, LAS unsigned char* lds, int gw, int NGW, int lane, int wave, int l) {
    {
        LAS float* wps = (LAS float*)(lds + wave * 12288);
        for (int it = gw; it < 4 * 8 * 16; it += NGW) {
            const int nb = it & 15, ib = (it >> 4) & 7, g = (it >> 7) & 3;
            const float* wp = ain(a, I_WPOOL) + ((size_t)(l * 4 + g) * 128 + ib * 16) * 128;
            const float* ps = ain(a, I_PSC) + l * 512 + g * 128;
            const float* wo = ain(a, I_WOUT) + ((size_t)l * D + 512 + g * 128) * D + nb * 64 + lane;
            { const int ii = lane >> 2, js = (lane & 3) * 32;
#pragma unroll
                for (int q = 0; q < 8; ++q) { const f32x4 w = *(const f32x4*)(wp + ii * 128 + js + 4 * q) * *(const f32x4*)(ps + js + 4 * q);
                    wps[(js + 4 * q + 0) * 16 + ii] = w.x; wps[(js + 4 * q + 1) * 16 + ii] = w.y; wps[(js + 4 * q + 2) * 16 + ii] = w.z; wps[(js + 4 * q + 3) * 16 + ii] = w.w; } }
            LDS_WAIT(); asm volatile("" ::: "memory");
            f32x4 acc[4];
#pragma unroll
            for (int i = 0; i < 4; ++i) acc[i] = (f32x4){0.f, 0.f, 0.f, 0.f};
#pragma unroll 32
            for (int j = 0; j < 128; ++j) { const float wv = wo[(size_t)j * D];
#pragma unroll
                for (int i = 0; i < 4; ++i) acc[i] += *(const LAS f32x4*)(wps + j * 16 + 4 * i) * wv; }
            bf16* dst = (bf16*)(ws + WS_WOUT) + ((size_t)l * D + nb * 64 + lane) * D + 512 + g * 128 + ib * 16;
            v4u o0, o1; o0.x = pk2(acc[0].x, acc[0].y); o0.y = pk2(acc[0].z, acc[0].w); o0.z = pk2(acc[1].x, acc[1].y); o0.w = pk2(acc[1].z, acc[1].w);
            o1.x = pk2(acc[2].x, acc[2].y); o1.y = pk2(acc[2].z, acc[2].w); o1.z = pk2(acc[3].x, acc[3].y); o1.w = pk2(acc[3].z, acc[3].w);
            *(v4u*)dst = o0; *(v4u*)(dst + 8) = o1;
            LDS_WAIT(); asm volatile("" ::: "memory");
        }
    }
}
__device__ __forceinline__ void convert_layer(const Args& a, unsigned char* ws, LAS unsigned char* lds, int gw, int NGW, int lane, int wave, int l, int part) {
    {
        LAS float* scr = (LAS float*)(lds + wave * 12288);
        constexpr int I_IN = 16 * 40, I_OUT = 8 * 32, I_UP = 16 * 176, I_DN = 44 * 32, I_L = I_IN + I_OUT + I_UP + I_DN;
        auto decode = [&](int it) -> TrItem {
            int r = it; TrItem t;
            if (r < I_IN) { const int kb = r / 40, nb = r % 40, n0 = nb * 32, pn = n0 >> 8, lc = n0 & 255, wc = lc >> 6, bj = (lc >> 5) & 1;
                t.src = ain(a, I_WIN) + (size_t)l * D * NIN + (size_t)(kb * 64) * NIN + n0; t.ldw = NIN;
                t.dst = (bf16*)(ws + WS_WIN) + (size_t)l * NIN * D + (size_t)(pn * 256 + bj * 128 + wc * 32) * D + kb * 64; t.ldt = D; return t; }
            r -= I_IN;
            if (r < I_OUT) { const int kb = r / 32, nb = r % 32;
                t.src = ain(a, I_WOUT) + (size_t)l * D * D + (size_t)(kb * 64) * D + nb * 32; t.ldw = D;
                t.dst = (bf16*)(ws + WS_WOUT) + (size_t)l * D * D + (size_t)(nb * 32) * D + kb * 64; t.ldt = D; return t; }
            r -= I_OUT;
            if (r < I_UP) { const int kb = r / 176, nb = r % 176, n0 = nb * 32, hf = n0 >= DFF, chn = n0 - hf * DFF;
                t.src = ain(a, I_WUP) + (size_t)l * D * NUP + (size_t)(kb * 64) * NUP + n0; t.ldw = NUP;
                t.dst = (bf16*)(ws + WS_WUP) + (size_t)l * NUP * D + (size_t)((chn >> 7) * 256 + hf * 128 + (chn & 127)) * D + kb * 64; t.ldt = D; return t; }
            r -= I_UP;
            { const int kb = r / 32, nb = r % 32;
                t.src = ain(a, I_WDN) + (size_t)l * DFF * D + (size_t)(kb * 64) * D + nb * 32; t.ldw = D;
                t.dst = (bf16*)(ws + WS_WDN) + (size_t)l * D * DFF + (size_t)(nb * 32) * DFF + kb * 64; t.ldt = DFF; return t; }
        };
        const int it0 = (part == 1 ? I_IN + I_OUT : 0) + gw, NIT = (part == 0 ? I_IN + I_OUT : I_L);
        if (it0 < NIT) {
            TrItem cur = decode(it0); float rc[32]; tr_load(cur, rc, lane);
            for (int it = it0; it < NIT; it += NGW) {
                const bool has = it + NGW < NIT; TrItem nxt = cur; float rn[32];
                if (has) { nxt = decode(it + NGW); tr_load(nxt, rn, lane); }
                tr_store(cur, rc, scr, lane);
                if (has) { cur = nxt;
#pragma unroll
                    for (int i = 0; i < 32; ++i) rc[i] = rn[i]; }
            }
        }
    }
}
__device__ __forceinline__ void prologue(const Args& a, LAS unsigned char* lds, int vcu, int G, int tid, int lane, int wave, int nl_pre) {
    size_t wz_ = 0; asm volatile("" : "+s"(wz_)); unsigned char* ws = a.ws + wz_;
    const int gw = vcu * NWAVES + wave, NGW = G * NWAVES;
    {
        typedef float f32x2_ __attribute__((ext_vector_type(2)));
        LAS f32x2_* red = (LAS f32x2_*)lds;
        const float* cc = ain(a, I_CCTX); const float* c1 = ain(a, I_C);
        for (int it = vcu; it < DEPTH * 48; it += G) {
            const int l = it / 48, cb = it % 48;
            const float* W = ain(a, I_WMOD) + (size_t)l * D * NMOD + cb * 128 + lane * 2;
            f32x2_ a0 = {0.f, 0.f}, a1 = a0, a2 = a0;
            const int kb = wave * 128;
#pragma unroll 32
            for (int k = 0; k < 128; ++k) {
                const f32x2_ w = *(const f32x2_*)(W + (size_t)(kb + k) * NMOD);
                const float s0 = silu_f(cc[kb + k]), s1 = silu_f(c1[kb + k]), s2 = silu_f(c1[D + kb + k]);
                a0 += w * s0; a1 += w * s1; a2 += w * s2;
            }
            red[(wave * 3 + 0) * 64 + lane] = a0; red[(wave * 3 + 1) * 64 + lane] = a1; red[(wave * 3 + 2) * 64 + lane] = a2;
            __syncthreads();
            if (tid < 192) { const int cnd = tid >> 6; f32x2_ s = *(const f32x2_*)(ain(a, I_BMOD) + (size_t)l * NMOD + cb * 128 + lane * 2);
#pragma unroll
                for (int w = 0; w < 8; ++w) s += red[(w * 3 + cnd) * 64 + lane];
                *(f32x2_*)((float*)(ws + WS_MOD) + ((size_t)l * 3 + cnd) * NMOD + cb * 128 + lane * 2) = s; }
            __syncthreads();
        }
    }
#ifdef PROBE_PRO2
    for (int rep_ = 0; rep_ < 2; ++rep_) {
#endif
    for (int it = gw * 64 + lane; it < 2 * DEPTH * PAST * 16 * 2; it += NGW * 64) {
        const int which = it & 1, r = it >> 1, c8 = r & 15, p = (r >> 4) & 511, l = (r >> 13) & 3, b = r >> 15;
        const float* src = a.in[which ? I_CV : I_CK] + (((size_t)(b * DEPTH + l) * PAST + p) * 128 + c8 * 8);
        const f32x4 x0 = *(const f32x4*)src, x1 = *(const f32x4*)(src + 4);
        v4u o; o.x = pk2(x0.x, x0.y); o.y = pk2(x0.z, x0.w); o.z = pk2(x1.x, x1.y); o.w = pk2(x1.z, x1.w);
        *(v4u*)((bf16*)(ws + (which ? WS_VL : WS_KL)) + (((size_t)(l * 2 + b) * LKEYS + p) * 128 + c8 * 8)) = o;
    }
    for (int l = 0; l < nl_pre; ++l) { weff_layer(a, ws, lds, gw, NGW, lane, wave, l); convert_layer(a, ws, lds, gw, NGW, lane, wave, l, 2); }
#ifdef PROBE_PRO2
    }
#endif
}

__device__ __forceinline__ void bias_rows(unsigned char* ws, int gw, int NGW, int lane, int l, bool up) {
    const float* mod = (const float*)(ws + WS_MOD);
    for (int n = gw; n < (up ? NUP : NIN); n += NGW) {
        const bf16* wrow = up ? (const bf16*)(ws + WS_WUP) + ((size_t)l * NUP + n) * D : (const bf16*)(ws + WS_WIN) + ((size_t)l * NIN + n) * D;
        const v4u w0 = *(const v4u*)(wrow + lane * 16), w1 = *(const v4u*)(wrow + lane * 16 + 8);
        float wf[16] = {bf_lo(w0.x), bf_hi(w0.x), bf_lo(w0.y), bf_hi(w0.y), bf_lo(w0.z), bf_hi(w0.z), bf_lo(w0.w), bf_hi(w0.w),
                        bf_lo(w1.x), bf_hi(w1.x), bf_lo(w1.y), bf_hi(w1.y), bf_lo(w1.z), bf_hi(w1.z), bf_lo(w1.w), bf_hi(w1.w)};
        float s[3];
#pragma unroll
        for (int c = 0; c < 3; ++c) { const float* sh = mod + ((size_t)l * 3 + c) * NMOD + (up ? 3 * D : 0) + lane * 16; float acc = 0.f;
#pragma unroll
            for (int q = 0; q < 4; ++q) { const f32x4 x = *(const f32x4*)(sh + 4 * q); acc += (x.x * wf[4 * q] + x.y * wf[4 * q + 1]) + (x.z * wf[4 * q + 2] + x.w * wf[4 * q + 3]); }
            s[c] = wave_sum(acc); }
        if (lane == 0) { float* o = up ? (float*)(ws + WS_B5) + (size_t)l * 3 * NUP + n : (float*)(ws + WS_B1) + (size_t)l * 3 * NIN + n; const int st = up ? NUP : NIN;
            o[0] = s[0]; o[st] = s[1]; o[2 * st] = s[2]; }
    }
}
__device__ __forceinline__ void phase1(const Args& a, int gw, int NGW, int lane, int nl_pre) {
    size_t wz_ = 0; asm volatile("" : "+s"(wz_)); unsigned char* ws = a.ws + wz_;
    const float* mod = (const float*)(ws + WS_MOD);
    for (int it = gw * 64 + lane; it < DEPTH * 2 * 3 * D; it += NGW * 64) {
        const int col = it & 1023, cnd = (it >> 10) % 3, w = ((it >> 10) / 3) & 1, l = (it >> 10) / 6;
        const float g = (w ? ain(a, I_N2G) : ain(a, I_N1G))[l * D + col];
        ((float*)(ws + WS_GM))[it] = g * (1.f + mod[((size_t)l * 3 + cnd) * NMOD + (w ? 4 * D : D) + col]);
    }
    for (int l = 0; l < nl_pre; ++l) { bias_rows(ws, gw, NGW, lane, l, false); bias_rows(ws, gw, NGW, lane, l, true); }
    bf16* X = (bf16*)(ws + WS_X);
    f32x4 g[4];
#pragma unroll
    for (int j = 0; j < 4; ++j) g[j] = *(const f32x4*)(ain(a, I_N1G) + 256 * j + lane * 4);
    for (int row = gw; row < M; row += NGW) {
        const float* src = row < NCTX ? ain(a, I_XP) + (size_t)row * D : ain(a, I_XS) + (size_t)(row - NCTX) * D;
        const float* sc = mod + (size_t)row_cond(row) * NMOD + D;
        bf16* h = (bf16*)(ws + WS_H) + (size_t)row * D;
        float s = 0.f;
#pragma unroll
        for (int j = 0; j < 4; ++j) { const f32x4 v = *(const f32x4*)(src + 256 * j + lane * 4); s += (v.x * v.x + v.y * v.y) + (v.z * v.z + v.w * v.w);
            const f32x4 y = v * g[j] * (*(const f32x4*)(sc + 256 * j + lane * 4) + 1.f);
            v2u o; o.x = pk2(y.x, y.y); o.y = pk2(y.z, y.w); *(v2u*)(h + 256 * j + lane * 4) = o;
            v2u xo_; xo_.x = pkh2(v.x, v.y); xo_.y = pkh2(v.z, v.w); *(v2u*)(X + (size_t)row * D + 256 * j + lane * 4) = xo_; }
        s = wave_sum(s);
        if (lane == 0) *(f32x4*)((float*)(ws + WS_RS) + (size_t)row * 4) = (f32x4){s, 0.f, 0.f, 0.f};
    }
}
__device__ __forceinline__ void final_norm(const Args& a, int gw, int NGW, int lane) {
    size_t wz_ = 0; asm volatile("" : "+s"(wz_)); unsigned char* ws = a.ws + wz_;     const bf16* X = (const bf16*)(ws + WS_X);
    f32x4 g[4];
#pragma unroll
    for (int j = 0; j < 4; ++j) g[j] = *(const f32x4*)(ain(a, I_FNG) + 256 * j + lane * 4);
    for (int row = gw; row < M; row += 2 * NGW) {
        const int row2 = row + NGW; const bool has2 = row2 < M;
        f32x4 v[4], w[4]; float s = 0.f, s2 = 0.f;
#pragma unroll
        for (int j = 0; j < 4; ++j) { const v2u a_ = *(const v2u*)(X + (size_t)row * D + 256 * j + lane * 4); v2u b_ = {0u, 0u}; if (has2) b_ = *(const v2u*)(X + (size_t)row2 * D + 256 * j + lane * 4);
            v[j] = (f32x4){h_lo(a_.x), h_hi(a_.x), h_lo(a_.y), h_hi(a_.y)}; w[j] = (f32x4){h_lo(b_.x), h_hi(b_.x), h_lo(b_.y), h_hi(b_.y)}; }
#pragma unroll
        for (int j = 0; j < 4; ++j) { s += (v[j].x * v[j].x + v[j].y * v[j].y) + (v[j].z * v[j].z + v[j].w * v[j].w); s2 += (w[j].x * w[j].x + w[j].y * w[j].y) + (w[j].z * w[j].z + w[j].w * w[j].w); }
        const float rstd = 1.f / sqrtf(wave_sum(s) * (1.f / D) + EPS), rstd2 = 1.f / sqrtf(wave_sum(s2) * (1.f / D) + EPS);
#pragma unroll
        for (int j = 0; j < 4; ++j) { *(f32x4*)(a.out + (size_t)row * D + 256 * j + lane * 4) = v[j] * rstd * g[j]; if (has2) *(f32x4*)(a.out + (size_t)row2 * D + 256 * j + lane * 4) = w[j] * rstd2 * g[j]; }
    }
}

#ifndef QKV_NOROPE
#define QKV_NOROPE
#endif
namespace pg8 {
__device__ __forceinline__ void rope2(float& x1, float& x2, float rev) { rev = rev - floorf(rev); const float sn = __builtin_amdgcn_sinf(rev), cs = __builtin_amdgcn_cosf(rev); const float a = x1 * cs - x2 * sn, b = x1 * sn + x2 * cs; x1 = a; x2 = b; }
template <int KIND> __device__ __forceinline__ void qkv_rows(const f32x4 (&acc)[2][2][4][2], bf16_t* dst0, int pitch, float* c0, const float* gp, bool lat, int t0, int fq, const float* rs0, const float* bp) {
    float rstd_in[2][4];
#pragma unroll
    for (int ai = 0; ai < 2; ++ai) {
#pragma unroll
        for (int m = 0; m < 4; ++m) { const f32x4 p_ = *(const f32x4*)(rs0 + (ai * HALF + m * 16) * 4); rstd_in[ai][m] = __builtin_amdgcn_rsqf(((p_.x + p_.y) + (p_.z + p_.w)) * (1.f / 1024.f) + 1e-6f); }
        asm volatile("" : "+v"(rstd_in[ai][0]), "+v"(rstd_in[ai][1]), "+v"(rstd_in[ai][2]), "+v"(rstd_in[ai][3]) :: "memory");
    }
    const f32x4 b00 = *(const f32x4*)(bp), b01 = *(const f32x4*)(bp + 16), b10 = *(const f32x4*)(bp + 128), b11 = *(const f32x4*)(bp + 144);
    f32x4 g00 = {1.f, 1.f, 1.f, 1.f}, g01 = g00, g10 = g00, g11 = g00;
    if (KIND < 2) { g00 = *(const f32x4*)(gp); g01 = *(const f32x4*)(gp + 16); g10 = *(const f32x4*)(gp + 32); g11 = *(const f32x4*)(gp + 48); }
    float i0 = 0.f, i1 = 0.f, i2 = 0.f, i3 = 0.f;
    if (KIND < 2) { const float k = -(13.287712379549449f / 16.0f), r2pi = 0.15915494309189535f;
        i0 = __builtin_amdgcn_exp2f((float)(4 * fq + 0) * k) * r2pi; i1 = __builtin_amdgcn_exp2f((float)(4 * fq + 1) * k) * r2pi;
        i2 = __builtin_amdgcn_exp2f((float)(4 * fq + 2) * k) * r2pi; i3 = __builtin_amdgcn_exp2f((float)(4 * fq + 3) * k) * r2pi; }
    const float qscale = KIND == 0 ? 0.125f * 1.4426950408889634f : 1.f;
#pragma unroll
    for (int ai = 0; ai < 2; ++ai)
#pragma unroll
        for (int m = 0; m < 4; ++m) {
            const int dr = ai * HALF + m * 16;
            bf16_t* dst = dst0; float* co = c0; asm volatile("" : "+v"(dst), "+v"(co));
            GAS bf16_t* dstg = (GAS bf16_t*)dst + dr * pitch; GAS float* cog = (GAS float*)co + dr * 128;
            const float ri = rstd_in[ai][m];
            f32x4 v00 = acc[ai][0][m][0] * ri + b00, v01 = acc[ai][0][m][1] * ri + b01, v10 = acc[ai][1][m][0] * ri + b10, v11 = acc[ai][1][m][1] * ri + b11;
            if (KIND < 2) {
                float ss = ((v00.x * v00.x + v00.y * v00.y) + (v00.z * v00.z + v00.w * v00.w)) + ((v01.x * v01.x + v01.y * v01.y) + (v01.z * v01.z + v01.w * v01.w))
                         + ((v10.x * v10.x + v10.y * v10.y) + (v10.z * v10.z + v10.w * v10.w)) + ((v11.x * v11.x + v11.y * v11.y) + (v11.z * v11.z + v11.w * v11.w));
                ss = ::xadd32(::xadd16(ss));
                const float rstd = __builtin_amdgcn_rsqf(ss * (1.f / 64.f) + 1e-6f);
                v00 = v00 * rstd * g00; v01 = v01 * rstd * g01; v10 = v10 * rstd * g10; v11 = v11 * rstd * g11;
                if (lat) {
                    const int t = t0 + dr; const float pr = (float)(t >> 6), pc = (float)(t & 63);
#define ROPE2(A, B, C, REV) do { float x1_ = A.C, x2_ = B.C; rope2(x1_, x2_, REV); A.C = x1_; B.C = x2_; } while (0)
                    ROPE2(v00, v01, x, pr * i0); ROPE2(v00, v01, y, pr * i1); ROPE2(v00, v01, z, pr * i2); ROPE2(v00, v01, w, pr * i3);
                    ROPE2(v10, v11, x, pc * i0); ROPE2(v10, v11, y, pc * i1); ROPE2(v10, v11, z, pc * i2); ROPE2(v10, v11, w, pc * i3);
#undef ROPE2
                }
            }
            if ((KIND == 1 || KIND == 2) && !lat) { *(GAS f32x4*)(cog) = v00; *(GAS f32x4*)(cog + 16) = v01; *(GAS f32x4*)(cog + 32) = v10; *(GAS f32x4*)(cog + 48) = v11; }
            typedef unsigned u32x2 __attribute__((ext_vector_type(2)));
            v00 = v00 * qscale; v01 = v01 * qscale; v10 = v10 * qscale; v11 = v11 * qscale;
            u32x2 w;
            w.x = cvt_pk_bf16(v00.x, v00.y); w.y = cvt_pk_bf16(v00.z, v00.w); *(GAS u32x2*)(dstg) = w;
            w.x = cvt_pk_bf16(v01.x, v01.y); w.y = cvt_pk_bf16(v01.z, v01.w); *(GAS u32x2*)(dstg + 16) = w;
            w.x = cvt_pk_bf16(v10.x, v10.y); w.y = cvt_pk_bf16(v10.z, v10.w); *(GAS u32x2*)(dstg + 32) = w;
            w.x = cvt_pk_bf16(v11.x, v11.y); w.y = cvt_pk_bf16(v11.z, v11.w); *(GAS u32x2*)(dstg + 48) = w;
            if (m & 1) __builtin_amdgcn_sched_barrier(0);
        }
}
struct EpiQKV {
    static constexpr bool PERM = false, AFTER_DRAIN = false;
    unsigned char* ws; float* out; const float *qg, *kg; int layer;
    __device__ __forceinline__ void operator()(const f32x4 (&acc)[2][2][4][2], const Unit& u, int wr, int wc, int fr, int fq) const {
        { int t_ = threadIdx.x; asm volatile("" : "+v"(t_)); fr = t_ & 15; fq = (t_ >> 4) & 3; }
        const int pn = u.pn; const bool lat = u.pm >= 32;
        const int cnd = u.pm < 32 ? 0 : 1 + ((u.pm - 32) >> 3);
        const float* rs0 = (const float*)(ws + WS_RS) + ((size_t)(2 * layer) * 12288 + (u.pm * BM + wr * 64 + fr)) * 4;
        const float* bp = (const float*)(ws + WS_B1) + ((size_t)layer * 3 + cnd) * 1280 + pn * BM + wc * 32 + 4 * fq;
        const int row0 = u.pm * BM + wr * 64 + fr;
        int t0 = (row0 - 8192) & 2047;
        asm volatile("" : "+v"(t0));
        if (pn < 2) {
            qkv_rows<0>(acc, (bf16_t*)(ws + WS_Q) + (size_t)row0 * 512 + (4 * pn + wc) * 64 + 4 * fq, 512, nullptr, qg + 4 * fq, lat, t0, fq, rs0, bp);
        } else if (pn == 2) {
            const int hh = wc & 1; const bool isk = wc < 2;
            size_t doff;
            if (!lat) doff = (isk ? WS_KC : WS_VC) + ((size_t)row0 * 128 + hh * 64) * 2;
            else { const int b = (row0 - 8192) >> 11; doff = (isk ? WS_KL : WS_VL) + (((size_t)(layer * 2 + b) * 2560 + 512 + ((row0 - 8192) & 2047)) * 128 + hh * 64) * 2; }
            bf16_t* dst0 = (bf16_t*)(ws + doff) + 4 * fq;
            float* c0 = out + (size_t)12288 * 1024 + (isk ? 0 : (size_t)32 * 4 * 256 * 128) + ((size_t)((row0 >> 8) * 4 + layer) * 256 + (row0 & 255)) * 128 + hh * 64 + 4 * fq;
            if (isk) qkv_rows<1>(acc, dst0, 128, c0, kg + 4 * fq, lat, t0, fq, rs0, bp); else qkv_rows<2>(acc, dst0, 128, c0, kg, lat, t0, fq, rs0, bp);
        } else {
            qkv_rows<3>(acc, (bf16_t*)(ws + WS_U) + (size_t)row0 * 512 + (pn - 3) * 256 + wc * 64 + 4 * fq, 512, nullptr, kg, lat, t0, fq, rs0, bp);
        }
    }
};
struct EpiRes {
    static constexpr bool PERM = true, AFTER_DRAIN = false;
    unsigned char* ws; const float* gate;
    int ninst;
    PG8_LAS float* XB;
    __device__ __forceinline__ void operator()(const f32x4 (&acc)[2][2][4][2], const Unit& u, int wr, int wc, int fr, int fq) const {
#ifdef PROBE_DUP
        if (ninst == -2) return;
#endif
        int tl; { int t_ = threadIdx.x; asm volatile("" : "+v"(t_)); fr = t_ & 15; fq = (t_ >> 4) & 3; tl = t_; }
        const int cnd = u.pm < 32 ? 0 : 1 + ((u.pm - 32) >> 3);
        const int col0 = u.pn * BM + wc * 32 + 8 * fq; const float* gp = gate + (size_t)cnd * 6144 + col0;
        const float* gm = (const float*)(ws + WS_GM) + ((size_t)(ninst < 0 ? 0 : ninst) * 3 + cnd) * 1024 + col0;
        const int row0 = u.pm * BM + wr * 64 + fr;
        bf16_t* x0 = (bf16_t*)(ws + WS_X) + (size_t)row0 * 1024 + col0;
        bf16_t* h0 = (bf16_t*)(ws + WS_H) + (size_t)row0 * 1024 + col0;
        f32x4 gt[2][2], gn[2][2];
#pragma unroll
        for (int bj = 0; bj < 2; ++bj)
#pragma unroll
            for (int n = 0; n < 2; ++n) { gt[bj][n] = *(const f32x4*)(gp + bj * HALF + 4 * n); gn[bj][n] = *(const f32x4*)(gm + bj * HALF + 4 * n); }
#pragma unroll
        for (int ai = 0; ai < 2; ++ai)
#pragma unroll
            for (int m = 0; m < 4; ++m) { const int dr = ai * HALF + m * 16;
                bf16_t* xr_ = x0; bf16_t* hr_ = h0; asm volatile("" : "+v"(xr_), "+v"(hr_)); GAS bf16_t* xr = (GAS bf16_t*)xr_ + dr * 1024; GAS bf16_t* hr = (GAS bf16_t*)hr_ + dr * 1024;
                float ss = 0.f;
#pragma unroll
                for (int bj = 0; bj < 2; ++bj) {
                    const u32x4 xo = *(const GAS u32x4*)(xr + bj * HALF);
                    const f32x4 o0 = {::h_lo(xo.x), ::h_hi(xo.x), ::h_lo(xo.y), ::h_hi(xo.y)}, o1 = {::h_lo(xo.z), ::h_hi(xo.z), ::h_lo(xo.w), ::h_hi(xo.w)};
                    const f32x4 x0v = o0 + gt[bj][0] * acc[ai][bj][m][0], x1v = o1 + gt[bj][1] * acc[ai][bj][m][1];
                    u32x4 xw; xw.x = ::pkh2(x0v[0], x0v[1]); xw.y = ::pkh2(x0v[2], x0v[3]); xw.z = ::pkh2(x1v[0], x1v[1]); xw.w = ::pkh2(x1v[2], x1v[3]);
                    *(GAS u32x4*)(xr + bj * HALF) = xw;
                    if (ninst >= 0) { ss += ((x0v.x * x0v.x + x0v.y * x0v.y) + (x0v.z * x0v.z + x0v.w * x0v.w)) + ((x1v.x * x1v.x + x1v.y * x1v.y) + (x1v.z * x1v.z + x1v.w * x1v.w));
                        const f32x4 y0 = x0v * gn[bj][0], y1 = x1v * gn[bj][1];
                        u32x4 hw; hw.x = cvt_pk_bf16(y0[0], y0[1]); hw.y = cvt_pk_bf16(y0[2], y0[3]); hw.z = cvt_pk_bf16(y1[0], y1[1]); hw.w = cvt_pk_bf16(y1[2], y1[3]);
                        *(GAS u32x4*)(hr + bj * HALF) = hw; } }
                if (ninst >= 0) { ss = ::xadd32(::xadd16(ss)); if (fq == 0) XB[wc * 256 + wr * 64 + fr + dr] = ss; }
                if (m == 3) asm volatile("" ::: "memory"); }
        if (ninst >= 0) {
            asm volatile("s_waitcnt lgkmcnt(0)" ::: "memory"); __builtin_amdgcn_s_barrier(); asm volatile("" ::: "memory");
            if (tl < 256) { const float s_ = (XB[tl] + XB[256 + tl]) + (XB[512 + tl] + XB[768 + tl]);
                ((float*)(ws + WS_RS))[((size_t)ninst * 12288 + u.pm * BM + tl) * 4 + u.pn] = s_; }
        }
    }
};
struct EpiZ {
    static constexpr bool PERM = true, AFTER_DRAIN = false;
    unsigned char* ws; int layer;
    __device__ __forceinline__ void operator()(const f32x4 (&acc)[2][2][4][2], const Unit& u, int wr, int wc, int fr, int fq) const {
        const int cnd = u.pm < 32 ? 0 : 1 + ((u.pm - 32) >> 3);
        const int row0 = u.pm * BM + wr * 64 + fr, col0 = u.pn * BM + wc * 32 + 8 * fq;
        const float* bias = (const float*)(ws + WS_B5) + ((size_t)layer * 3 + cnd) * 5632 + col0;
        const float* rs0 = (const float*)(ws + WS_RS) + (size_t)(2 * layer + 1) * 12288 + row0;
        bf16_t* z0 = (bf16_t*)(ws + WS_Z) + (size_t)row0 * 5632 + col0;
        f32x4 bv[2][2];
#pragma unroll
        for (int bj = 0; bj < 2; ++bj)
#pragma unroll
            for (int n = 0; n < 2; ++n) bv[bj][n] = *(const f32x4*)(bias + bj * HALF + 4 * n);
#pragma unroll
        for (int ai = 0; ai < 2; ++ai)
#pragma unroll
            for (int m = 0; m < 4; ++m) { const int dr = ai * HALF + m * 16;
                bf16_t* zr_ = z0; const float* rsp = rs0; asm volatile("" : "+v"(zr_), "+v"(rsp)); GAS bf16_t* zr = (GAS bf16_t*)zr_ + (size_t)dr * 5632;
                const float rstd = 1.f / sqrtf(((const GAS float*)rsp)[dr] * (1.f / 1024.f) + 1e-6f);
#pragma unroll
                for (int bj = 0; bj < 2; ++bj) { const f32x4 v0 = acc[ai][bj][m][0] * rstd + bv[bj][0], v1 = acc[ai][bj][m][1] * rstd + bv[bj][1];
                    u32x4 w; w.x = cvt_pk_bf16(v0[0], v0[1]); w.y = cvt_pk_bf16(v0[2], v0[3]); w.z = cvt_pk_bf16(v1[0], v1[1]); w.w = cvt_pk_bf16(v1[2], v1[3]);
                    *(GAS u32x4*)(zr + bj * HALF) = w; } }
    }
};
template <int CTRL> __device__ __forceinline__ f32x4 dpp4(const f32x4 v) { f32x4 r;
#pragma unroll
    for (int c = 0; c < 4; ++c) r[c] = __int_as_float(__builtin_amdgcn_update_dpp(0, __float_as_int(v[c]), CTRL, 0xf, 0xf, false)); return r; }
struct EpiConv {
    static constexpr bool PERM = true, AFTER_DRAIN = false;
    unsigned char* ws; const float* cw; const float* cb; PG8_LAS float* XB; int layer;
    __device__ __forceinline__ void operator()(f32x4 (&acc)[2][2][4][2], const Unit& u, int wr, int wc, int fr, int fq) const {
        int tl; { int t_ = threadIdx.x; asm volatile("" : "+v"(t_)); fr = t_ & 15; fq = (t_ >> 4) & 3; tl = t_; }
        PG8_LAS float* WL = XB + 2048;
        float wl0, wl1; { const int k0 = tl >> 7, k1 = k0 + 4, c = tl & 127; const unsigned cbase = (unsigned)(u.pn * HALF + c);
            wl0 = k0 < 3 ? cw[cbase + (unsigned)(k0 * 5632)] : cb[cbase];
            wl1 = k0 < 3 ? cw[cbase + (unsigned)(k0 * 5632 + 2816)] : cb[cbase + 2816u]; (void)k1; }
        const int cnd = u.pm < 32 ? 0 : 1 + ((u.pm - 32) >> 3); const bool lat = u.pm >= 32;
        const int ci0 = wc * 32 + 8 * fq, row0 = u.pm * BM + wr * 64 + fr;
        {
            const float* bias = (const float*)(ws + WS_B5) + ((size_t)layer * 3 + cnd) * 5632 + u.pn * BM + ci0;
            const float* rs0 = (const float*)(ws + WS_RS) + ((size_t)(2 * layer + 1) * 12288 + row0) * 4;
            float rstd[2][4];
#pragma unroll
            for (int ai = 0; ai < 2; ++ai) {
#pragma unroll
                for (int m = 0; m < 4; ++m) { const f32x4 p_ = *(const f32x4*)(rs0 + (ai * HALF + m * 16) * 4); rstd[ai][m] = __builtin_amdgcn_rsqf(((p_.x + p_.y) + (p_.z + p_.w)) * (1.f / 1024.f) + 1e-6f); }
                asm volatile("" : "+v"(rstd[ai][0]), "+v"(rstd[ai][1]), "+v"(rstd[ai][2]), "+v"(rstd[ai][3]) :: "memory");
            }
#pragma unroll
            for (int bj = 0; bj < 2; ++bj) {
                const f32x4 b0 = *(const f32x4*)(bias + bj * HALF), b1 = *(const f32x4*)(bias + bj * HALF + 4);
#pragma unroll
                for (int ai = 0; ai < 2; ++ai)
#pragma unroll
                    for (int m = 0; m < 4; ++m) { acc[ai][bj][m][0] = acc[ai][bj][m][0] * rstd[ai][m] + b0; acc[ai][bj][m][1] = acc[ai][bj][m][1] * rstd[ai][m] + b1; }
                asm volatile("" ::: "memory");
            }
        }
#pragma unroll
        for (int ai = 0; ai < 2; ++ai) { const int blk = 2 * ai + wr;
#pragma unroll
            for (int bj = 0; bj < 2; ++bj)
#pragma unroll
                for (int n = 0; n < 2; ++n) {
                    if (fr == 0) *(PG8_LAS f32x4*)(XB + (blk * 2 + 0) * 256 + bj * HALF + ci0 + 4 * n) = acc[ai][bj][0][n];
                    if (fr == 15) *(PG8_LAS f32x4*)(XB + (blk * 2 + 1) * 256 + bj * HALF + ci0 + 4 * n) = acc[ai][bj][3][n]; } }
        if (lat) { float* hb = (float*)(ws + WS_HALO) + (size_t)(u.pm - 32) * 4 * 5632 + u.pn * BM + ci0;
            if (wr == 0 && fr < 2) {
#pragma unroll
                for (int bj = 0; bj < 2; ++bj)
#pragma unroll
                    for (int n = 0; n < 2; ++n) *(f32x4*)(hb + (size_t)fr * 5632 + bj * HALF + 4 * n) = acc[0][bj][0][n]; }
            if (wr == 1 && fr >= 14) {
#pragma unroll
                for (int bj = 0; bj < 2; ++bj)
#pragma unroll
                    for (int n = 0; n < 2; ++n) *(f32x4*)(hb + (size_t)(fr - 12) * 5632 + bj * HALF + 4 * n) = acc[1][bj][3][n]; } }
        WL[tl] = wl0; WL[512 + tl] = wl1;
        asm volatile("s_waitcnt lgkmcnt(0)" ::: "memory"); __builtin_amdgcn_s_barrier(); asm volatile("" ::: "memory");
        const int ch0 = u.pn * HALF + ci0;
        bf16_t* actb = (bf16_t*)(ws + WS_ACT); const unsigned aoff0 = (unsigned)(row0 * 2816 + ch0);
#pragma unroll
        for (int n = 0; n < 2; ++n) {
#pragma unroll
            for (int ai = 0; ai < 2; ++ai) { const int blk = 2 * ai + wr;
#pragma unroll
                for (int bj = 0; bj < 2; ++bj) {
                    const PG8_LAS float* wlp = WL + bj * 512 + ci0 + 4 * n;
                    const f32x4 w0 = *(const PG8_LAS f32x4*)(wlp), w1 = *(const PG8_LAS f32x4*)(wlp + 128), w2 = *(const PG8_LAS f32x4*)(wlp + 256), bb = *(const PG8_LAS f32x4*)(wlp + 384);
                    f32x4 edge_prev = {0.f, 0.f, 0.f, 0.f}, edge_next = {0.f, 0.f, 0.f, 0.f};
                    if (blk > 0) edge_prev = *(const PG8_LAS f32x4*)(XB + ((blk - 1) * 2 + 1) * 256 + bj * HALF + ci0 + 4 * n);
                    if (blk < 3) edge_next = *(const PG8_LAS f32x4*)(XB + ((blk + 1) * 2 + 0) * 256 + bj * HALF + ci0 + 4 * n);
                    f32x4 orig = edge_prev;
#pragma unroll
                    for (int m = 0; m < 4; ++m) {
                        const f32x4 z = acc[ai][bj][m][n];
                        f32x4 pv = dpp4<0x121>(z), nx = dpp4<0x12F>(z);
                        const f32x4 e = m > 0 ? dpp4<0x121>(orig) : edge_prev;
                        const f32x4 g = m < 3 ? dpp4<0x12F>(acc[ai][bj][m < 3 ? m + 1 : 3][n]) : edge_next;
                        if (fr == 0) pv = e;
                        if (fr == 15) nx = g;
                        acc[ai][bj][m][n] = pv * w0 + z * w1 + nx * w2 + bb;
                        orig = z;
                    }
                    __builtin_amdgcn_sched_barrier(0); asm volatile("" ::: "memory");
                }
#pragma unroll
                for (int m = 0; m < 4; ++m) { const f32x4 av = acc[ai][0][m][n], gv = acc[ai][1][m][n]; f32x4 o;
#pragma unroll
                    for (int c = 0; c < 4; ++c) o[c] = av[c] * __builtin_amdgcn_rcpf(1.f + __expf(-av[c])) * gv[c];
                    typedef unsigned u32x2 __attribute__((ext_vector_type(2))); u32x2 w; w.x = cvt_pk_bf16(o[0], o[1]); w.y = cvt_pk_bf16(o[2], o[3]);
                    { unsigned ao_ = aoff0; asm volatile("" : "+v"(ao_)); *(u32x2*)(actb + (ao_ + (unsigned)((ai * HALF + m * 16) * 2816 + 4 * n))) = w; }
                }
                __builtin_amdgcn_sched_barrier(0); asm volatile("" ::: "memory");
            }
        }
    }
};
}

__device__ __forceinline__ void conv_fixup(unsigned char* ws, const float* cw, const float* cb, int pm, int tid) {
    const int lt = pm - 32, tq = lt & 7; const float* H = (const float*)(ws + WS_HALO); bf16* ACT = (bf16*)(ws + WS_ACT);
#pragma unroll
    for (int rep = 0; rep < 3; ++rep) { const int idx = tid + rep * NTHR;
        if (idx < 2 * (DFF / 4)) {
            const int which = idx >= DFF / 4, ch = (idx - which * (DFF / 4)) * 4;
            if (!((which == 0 && tq == 0) || (which == 1 && tq == 7))) {
                const int pa = (ch >> 7) * 256 + (ch & 127), pg = pa + 128;
                const float *zp, *zc, *zn;
                if (which == 0) { zp = H + (size_t)((lt - 1) * 4 + 3) * NUP; zc = H + (size_t)(lt * 4 + 0) * NUP; zn = H + (size_t)(lt * 4 + 1) * NUP; }
                else { zp = H + (size_t)(lt * 4 + 2) * NUP; zc = H + (size_t)(lt * 4 + 3) * NUP; zn = H + (size_t)((lt + 1) * 4 + 0) * NUP; }
                const f32x4 av = *(const f32x4*)(zp + pa) * *(const f32x4*)(cw + ch) + *(const f32x4*)(zc + pa) * *(const f32x4*)(cw + NUP + ch) + *(const f32x4*)(zn + pa) * *(const f32x4*)(cw + 2 * NUP + ch) + *(const f32x4*)(cb + ch);
                const f32x4 gv = *(const f32x4*)(zp + pg) * *(const f32x4*)(cw + DFF + ch) + *(const f32x4*)(zc + pg) * *(const f32x4*)(cw + NUP + DFF + ch) + *(const f32x4*)(zn + pg) * *(const f32x4*)(cw + 2 * NUP + DFF + ch) + *(const f32x4*)(cb + DFF + ch);
                f32x4 o;
#pragma unroll
                for (int c = 0; c < 4; ++c) o[c] = av[c] / (1.f + __expf(-av[c])) * gv[c];
                v2u w; w.x = pk2(o[0], o[1]); w.y = pk2(o[2], o[3]);
                *(v2u*)(ACT + (size_t)(pm * 256 + (which ? 255 : 0)) * DFF + ch) = w;
            }
        }
    }
    asm volatile("s_waitcnt vmcnt(0)" ::: "memory"); __syncthreads();
}

template <int W> __device__ __forceinline__ void pool_item(const bf16* U, bf16* AO, int r0, int ch) {
    constexpr int HW = W / 2, NR = 8 + W - 1;
    int s0, L; if (r0 < NCTX) { s0 = r0 & ~255; L = 256; } else { s0 = NCTX + ((r0 - NCTX) & ~2047); L = 2048; }
    const int t0 = r0 - s0;
    v4u x[NR];
#pragma unroll
    for (int i = 0; i < NR; ++i) { const int t = t0 - HW + i; x[i] = (v4u){0u, 0u, 0u, 0u}; if (t >= 0 && t < L) x[i] = *(const v4u*)(U + (size_t)(s0 + t) * 512 + ch * 8); }
#define PL_LO(V_) ((f32x4){bf_lo((V_).x), bf_hi((V_).x), bf_lo((V_).y), bf_hi((V_).y)})
#define PL_HI(V_) ((f32x4){bf_lo((V_).z), bf_hi((V_).z), bf_lo((V_).w), bf_hi((V_).w)})
    f32x4 s0v = {0.f, 0.f, 0.f, 0.f}, s1v = s0v;
#pragma unroll
    for (int i = 0; i < W; ++i) { s0v += PL_LO(x[i]); s1v += PL_HI(x[i]); }
#pragma unroll
    for (int i = 0; i < 8; ++i) {
        const int t = t0 + i; const float rc = 1.f / (float)(min(t + HW, L) - max(t - HW, 0));
        const f32x4 o0 = s0v * rc - PL_LO(x[i + HW]), o1 = s1v * rc - PL_HI(x[i + HW]);
        v4u o; o.x = pk2(o0.x, o0.y); o.y = pk2(o0.z, o0.w); o.z = pk2(o1.x, o1.y); o.w = pk2(o1.z, o1.w);
        *(v4u*)(AO + (size_t)(r0 + i) * 1024 + 512 + ch * 8) = o;
        if (i < 7) { s0v += PL_LO(x[i + W]) - PL_LO(x[i]); s1v += PL_HI(x[i + W]) - PL_HI(x[i]); }
    }
#undef PL_LO
#undef PL_HI
}
__device__ __forceinline__ void pool_phase(unsigned char* ws, int gtid, int NT_) {
    const bf16* U = (const bf16*)(ws + WS_U); bf16* AO = (bf16*)(ws + WS_AO);
    constexpr int PER_G = (M / 8) * 16;
    for (int it = gtid; it < 4 * PER_G; it += NT_) {
        const int g = it / PER_G, rem = it % PER_G, ch = g * 16 + (rem & 15), r0 = (rem >> 4) * 8;
        if (g == 0) pool_item<2>(U, AO, r0, ch); else if (g == 1) pool_item<4>(U, AO, r0, ch); else if (g == 2) pool_item<8>(U, AO, r0, ch); else pool_item<16>(U, AO, r0, ch);
    }
}

__device__ __forceinline__ void conv_phase(const Args& a, int l, int gtid, int NT_) {
    size_t wz_ = 0; asm volatile("" : "+s"(wz_)); unsigned char* ws = a.ws + wz_;     const bf16* Z = (const bf16*)(ws + WS_Z); bf16* ACT = (bf16*)(ws + WS_ACT);
    const float* cw = ain(a, I_CW) + (size_t)l * 3 * NUP; const float* cb = ain(a, I_CB) + (size_t)l * NUP;
    constexpr int NCH = DFF / 8, RUN = 8;
    for (int it = gtid; it < (M / RUN) * NCH; it += NT_) {
        const int ch = it % NCH, run = it / NCH, r0 = run * RUN, c0 = ch * 8;
        const int L = r0 < NCTX ? 256 : 2048; const int t0 = (r0 < NCTX ? r0 : r0 - NCTX) & (L - 1);
        v4u za[RUN + 2], zg[RUN + 2];
#pragma unroll
        for (int i = 0; i < RUN + 2; ++i) { const int t = t0 + i - 1; const bool ok = (t >= 0) && (t < L);
            const bf16* p = Z + (size_t)(r0 + i - 1) * NUP + c0;
            za[i] = (v4u){0u, 0u, 0u, 0u}; zg[i] = za[i];
            if (ok) { za[i] = *(const v4u*)p; zg[i] = *(const v4u*)(p + DFF); } }
        f32x4 wa[3][2], wg[3][2], ba[2], bg[2];
#pragma unroll
        for (int k = 0; k < 3; ++k)
#pragma unroll
            for (int q = 0; q < 2; ++q) { wa[k][q] = *(const f32x4*)(cw + (size_t)k * NUP + c0 + 4 * q); wg[k][q] = *(const f32x4*)(cw + (size_t)k * NUP + DFF + c0 + 4 * q); }
#pragma unroll
        for (int q = 0; q < 2; ++q) { ba[q] = *(const f32x4*)(cb + c0 + 4 * q); bg[q] = *(const f32x4*)(cb + DFF + c0 + 4 * q); }
#define CV_LO(V_) ((f32x4){bf_lo((V_).x), bf_hi((V_).x), bf_lo((V_).y), bf_hi((V_).y)})
#define CV_HI(V_) ((f32x4){bf_lo((V_).z), bf_hi((V_).z), bf_lo((V_).w), bf_hi((V_).w)})
#pragma unroll
        for (int i = 0; i < RUN; ++i) {
            const f32x4 a0 = CV_LO(za[i]) * wa[0][0] + CV_LO(za[i + 1]) * wa[1][0] + CV_LO(za[i + 2]) * wa[2][0] + ba[0];
            const f32x4 a1 = CV_HI(za[i]) * wa[0][1] + CV_HI(za[i + 1]) * wa[1][1] + CV_HI(za[i + 2]) * wa[2][1] + ba[1];
            const f32x4 g0 = CV_LO(zg[i]) * wg[0][0] + CV_LO(zg[i + 1]) * wg[1][0] + CV_LO(zg[i + 2]) * wg[2][0] + bg[0];
            const f32x4 g1 = CV_HI(zg[i]) * wg[0][1] + CV_HI(zg[i + 1]) * wg[1][1] + CV_HI(zg[i + 2]) * wg[2][1] + bg[1];
            f32x4 o0, o1;
#pragma unroll
            for (int c = 0; c < 4; ++c) { o0[c] = a0[c] * __builtin_amdgcn_rcpf(1.f + __expf(-a0[c])) * g0[c]; o1[c] = a1[c] * __builtin_amdgcn_rcpf(1.f + __expf(-a1[c])) * g1[c]; }
            v4u ov; ov.x = pk2(o0.x, o0.y); ov.y = pk2(o0.z, o0.w); ov.z = pk2(o1.x, o1.y); ov.w = pk2(o1.z, o1.w);
            *(v4u*)(ACT + (size_t)(r0 + i) * DFF + c0) = ov;
        }
#undef CV_LO
#undef CV_HI
    }
}
#define XB_TMO      128
#define XB_XCNT(j)  (256  + 64 * (j))
#define XB_XSUB(j)  (1280 + 64 * (j))
#define XB_XGEN(j)  (2304 + 64 * (j))
#define XB_TOP      3328
#define XB_TOPGEN   3392
#define XCD_BAR_WORDS 3456
#define XB_SPIN_CAP (1u << 18)

__device__ __forceinline__ unsigned xb_ld(unsigned* p)              { return __hip_atomic_load(p, __ATOMIC_RELAXED, __HIP_MEMORY_SCOPE_AGENT); }
__device__ __forceinline__ unsigned xb_add(unsigned* p, unsigned v) { return __hip_atomic_fetch_add(p, v, __ATOMIC_RELAXED, __HIP_MEMORY_SCOPE_AGENT); }
__device__ __forceinline__ unsigned xb_xcc_id() { return (unsigned)__builtin_amdgcn_s_getreg((3 << 11) | 20) & 0xFu; }
#define XB_SPIN(cond, bar) do { unsigned _sp = 0; while (cond) { __builtin_amdgcn_s_sleep(1); \
    if ((++_sp & 255u) == 0u) { if (xb_ld(&(bar)[XB_TMO])) break; if (_sp > XB_SPIN_CAP) { atomicAdd(&(bar)[XB_TMO], 1u); break; } } } } while (0)

struct XcdBarrier {
    unsigned* bar; unsigned x;
    volatile LAS unsigned* st;
};

__device__ __forceinline__ XcdBarrier xcd_barrier_post(unsigned* bar, volatile LAS unsigned* st) {
    XcdBarrier b; b.bar = bar; b.x = xb_xcc_id(); b.st = st;
    if (threadIdx.x == 0) (void)xb_add(&bar[XB_XCNT(b.x)], 1u);
    return b;
}
__device__ __forceinline__ void xcd_barrier_complete(unsigned* bar, unsigned x, unsigned& nloc, unsigned& nx) {
    const unsigned G = gridDim.x * gridDim.y * gridDim.z;
    unsigned sum, cnt, mine, sp = 0u;
    for (;;) {
        sum = 0u; cnt = 0u; mine = 0u;
#pragma unroll
        for (unsigned j = 0; j < 16; ++j) { const unsigned c = xb_ld(&bar[XB_XCNT(j)]); sum += c; cnt += (c > 0u) ? 1u : 0u; mine = (j == x) ? c : mine; }
        if (sum == G) break;
        __builtin_amdgcn_s_sleep(1);
        if ((++sp & 255u) == 0u) { if (xb_ld(&bar[XB_TMO])) break; if (sp > XB_SPIN_CAP) { atomicAdd(&bar[XB_TMO], 1u); break; } }
    }
    nloc = mine > 0u ? mine : 1u; nx = cnt > 0u ? cnt : 1u;
}

__device__ __forceinline__ void xcd_barrier(const XcdBarrier& b) {
    asm volatile("s_waitcnt vmcnt(0)" ::: "memory");
    __syncthreads();
    if (threadIdx.x == 0) {
        unsigned* bar = b.bar;
        __builtin_amdgcn_s_waitcnt(0);
        unsigned nloc = b.st[0], nx = b.st[1];
        if (nloc == 0u) { xcd_barrier_complete(bar, b.x, nloc, nx); b.st[0] = nloc; b.st[1] = nx; }
        const unsigned old = xb_add(&bar[XB_XSUB(b.x)], 1u);
        const unsigned gen = old / nloc;
        if (old + 1u == (gen + 1u) * nloc) {
            __builtin_amdgcn_fence(__ATOMIC_RELEASE, "agent");
            asm volatile("s_waitcnt vmcnt(0)" ::: "memory");
            const unsigned og = xb_add(&bar[XB_TOP], 1u);
            const unsigned tg = og / nx;
            if (og + 1u == (tg + 1u) * nx) xb_add(&bar[XB_TOPGEN], 1u);
            else XB_SPIN(xb_ld(&bar[XB_TOPGEN]) == tg, bar);
            __builtin_amdgcn_fence(__ATOMIC_ACQUIRE, "agent");
            xb_add(&bar[XB_XGEN(b.x)], 1u);
            asm volatile("s_waitcnt vmcnt(0)" ::: "memory");
        } else {
            XB_SPIN(xb_ld(&bar[XB_XGEN(b.x)]) == gen, bar);
            __builtin_amdgcn_fence(__ATOMIC_ACQUIRE, "agent");
            asm volatile("s_waitcnt vmcnt(0)" ::: "memory");
        }
    }
    __syncthreads();
}

#ifdef SKIP0
#define SK0(...) do{}while(0)
#else
#define SK0(...) __VA_ARGS__
#endif
#ifdef SKIP1
#define SK1(...) do{}while(0)
#else
#define SK1(...) __VA_ARGS__
#endif
#ifdef SKIP2
#define SK2(...) do{}while(0)
#else
#define SK2(...) __VA_ARGS__
#endif
#ifdef SKIP3
#define SK3(...) do{}while(0)
#else
#define SK3(...) __VA_ARGS__
#endif
#ifdef SKIP4
#define SK4(...) do{}while(0)
#else
#define SK4(...) __VA_ARGS__
#endif
#ifdef SKIP5
#define SK5(...) do{}while(0)
#else
#define SK5(...) __VA_ARGS__
#endif
constexpr int NPH_L = 5;
constexpr int NPHASE = 2 + NPH_L * DEPTH + 1;
__global__ void __launch_bounds__(NTHR, 2) mega_fwd(Args a) {
    extern __shared__ __attribute__((aligned(16))) unsigned char lds_raw[];
    cg::grid_group grid = cg::this_grid();
    LAS unsigned char* lds = (LAS unsigned char*)lds_raw;
    volatile LAS unsigned* bst = (volatile LAS unsigned*)(lds + 131072 + 64);
    if (threadIdx.x < 2) bst[threadIdx.x] = 0u;
    __syncthreads();
    XcdBarrier xbar = xcd_barrier_post((unsigned*)a.ws, bst);
#ifdef PROBE_DUP
    for (int ph2 = 2 * a.ph_lo; ph2 < 2 * a.ph_hi; ++ph2) {
        const int ph = ph2 >> 1;
        if ((ph2 & 1) && !(ph >= 2 && ph < NPHASE - 1 && (ph - 2) % NPH_L == PROBE_DUP)) continue;
#else
    for (int ph = a.ph_lo; ph < a.ph_hi; ++ph) {
#endif
        int G = gridDim.x, bx = blockIdx.x; asm volatile("" : "+s"(G), "+s"(bx));
        const int vcu = (G % 8 == 0) ? (bx % 8) * (G / 8) + bx / 8 : bx;
        const int NGW = G * NWAVES, NGT = G * NTHR;
        const int n_idle = G - 192; const bool defer = n_idle >= 32; const int nl_pre = defer ? 1 : DEPTH;
#define TIDS() int tid = threadIdx.x; asm volatile("" : "+v"(tid)); const int lane = tid & 63, wave = __builtin_amdgcn_readfirstlane(tid >> 6); const int gw = vcu * NWAVES + wave, gtid = vcu * NTHR + tid; (void)lane; (void)gw; (void)gtid
        size_t wz_ = 0; asm volatile("" : "+s"(wz_)); unsigned char* ws = a.ws + wz_;
        float* mod = (float*)(ws + WS_MOD);
        if (ph == 0) { TIDS(); SK0(prologue(a, lds, vcu, G, tid, lane, wave, nl_pre)); }
        else if (ph == 1) { TIDS(); phase1(a, gw, NGW, lane, nl_pre); }
        else if (ph == NPHASE - 1) { TIDS(); final_norm(a, gw, NGW, lane); }
        else {
            const int l = (ph - 2) / NPH_L, s = (ph - 2) % NPH_L;
            if (s == 0) {
                pg8::Gemm g{(const pg8::bf16_t*)(ws + WS_H), (const pg8::bf16_t*)(ws + WS_WIN) + (size_t)l * NIN * D, M, NIN, D};
                pg8::StaticOrder S; S.init(M, NIN, G, bx);
                pg8::EpiQKV E{ws, a.out, ain(a, I_QG) + l * 64, ain(a, I_KG) + l * 64, l};
                SK1(pg8::gemm_phase<pg8::EpiQKV, pg8::StaticOrder, true, true>(lds, g, S, E));
            } else if (s == 1) {
                TIDS();
#ifndef ATT_SPLIT
                pool_phase(ws, gtid, NGT);
                const attn_body::bf16* Qb = (const attn_body::bf16*)(ws + WS_Q); attn_body::bf16* AOb = (attn_body::bf16*)(ws + WS_AO);
                for (int idx = vcu; idx < 512; idx += G) {
                    const attn_body::bf16 *Q0, *Kh, *Vh; attn_body::bf16* O0; int NT, ncomp;
                    if (idx < 256) { const int b = idx >> 7, h = (idx >> 4) & 7, qb = idx & 15; const size_t r0 = (size_t)NCTX + b * LSEQ + qb * 128;
                        Q0 = Qb + r0 * 512 + h * 64; O0 = AOb + r0 * 1024 + h * 64; NT = LKEYS / 64; ncomp = 4;
                        Kh = (const attn_body::bf16*)(ws + WS_KL) + ((size_t)(l * 2 + b) * LKEYS) * 128 + (h >> 2) * 64;
                        Vh = (const attn_body::bf16*)(ws + WS_VL) + ((size_t)(l * 2 + b) * LKEYS) * 128 + (h >> 2) * 64;
                    } else { const int u = idx - 256, b = u >> 3, h = u & 7; const size_t r0 = (size_t)b * SEQ;
                        Q0 = Qb + r0 * 512 + h * 64; O0 = AOb + r0 * 1024 + h * 64; NT = SEQ / 64; ncomp = 8;
                        Kh = (const attn_body::bf16*)(ws + WS_KC) + r0 * 128 + (h >> 2) * 64;
                        Vh = (const attn_body::bf16*)(ws + WS_VC) + r0 * 128 + (h >> 2) * 64; }
                    SK2(attn_body::attn_unit<8>(Q0, Kh, Vh, O0, NT, (char*)lds_raw, 0, nullptr, nullptr, nullptr, ncomp));
                }
#else
                pool_phase(ws, gtid, NGT);
                const attn_body::bf16* Qb = (const attn_body::bf16*)(ws + WS_Q); attn_body::bf16* AOb = (attn_body::bf16*)(ws + WS_AO);
                for (int idx = vcu; idx < 512; idx += G) {
                    const attn_body::bf16 *Q0, *Kh, *Vh; attn_body::bf16* O0; int NT, split = 0; float* part = nullptr; const float* partner = nullptr; unsigned* cnt = nullptr;
                    if (idx < 256) { const int un = idx >> 1, hf = idx & 1, b = un >> 6, h = (un >> 3) & 7, qb = un & 7; const size_t r0 = (size_t)NCTX + b * LSEQ + qb * 256;
                        Q0 = Qb + r0 * 512 + h * 64; O0 = AOb + r0 * 1024 + h * 64; NT = LKEYS / 128; split = 1;
                        Kh = (const attn_body::bf16*)(ws + WS_KL) + ((size_t)(l * 2 + b) * LKEYS + hf * (LKEYS / 2)) * 128 + (h >> 2) * 64;
                        Vh = (const attn_body::bf16*)(ws + WS_VL) + ((size_t)(l * 2 + b) * LKEYS + hf * (LKEYS / 2)) * 128 + (h >> 2) * 64;
                        part = (float*)(ws + WS_APART) + (size_t)idx * APART_FLOATS; partner = (const float*)(ws + WS_APART) + (size_t)(idx ^ 1) * APART_FLOATS;
                        cnt = (unsigned*)(ws + WS_ACNT) + ((size_t)l * 128 + un) * 8;
                    } else { const int u = idx - 256, b = u >> 3, h = u & 7; const size_t r0 = (size_t)b * SEQ;
                        Q0 = Qb + r0 * 512 + h * 64; O0 = AOb + r0 * 1024 + h * 64; NT = SEQ / 64;
                        Kh = (const attn_body::bf16*)(ws + WS_KC) + r0 * 128 + (h >> 2) * 64;
                        Vh = (const attn_body::bf16*)(ws + WS_VC) + r0 * 128 + (h >> 2) * 64; }
                    SK2(attn_body::attn_unit<8>(Q0, Kh, Vh, O0, NT, (char*)lds_raw, split, part, partner, cnt, 8));
                }
#endif
            } else if (s == 2 || s == 4) {
                const bool dn = (s == 4);
                pg8::Gemm g{(const pg8::bf16_t*)(ws + (dn ? WS_ACT : WS_AO)), dn ? (const pg8::bf16_t*)(ws + WS_WDN) + (size_t)l * D * DFF : (const pg8::bf16_t*)(ws + WS_WOUT) + (size_t)l * D * D, M, D, dn ? DFF : D};
                pg8::StaticOrder S; S.init(M, D, G, bx);
                if (defer && bx >= 192) {
                    TIDS(); const int iw = (bx - 192) * NWAVES + wave, NIW = n_idle * NWAVES;
                    if (!dn) { if (l + 1 < DEPTH) convert_layer(a, ws, lds, iw, NIW, lane, wave, l + 1, 0);
                               if (l >= 1) bias_rows(ws, iw, NIW, lane, l, true); }
                    else if (l + 1 < DEPTH) { weff_layer(a, ws, lds, iw, NIW, lane, wave, l + 1);
                                              bias_rows(ws, iw, NIW, lane, l + 1, false); }
                }
                if (dn) { TIDS(); pg8::Unit u0; if (S.next(0, u0) && u0.pm >= 32) conv_fixup(ws, ain(a, I_CW) + (size_t)l * 3 * NUP, ain(a, I_CB) + (size_t)l * NUP, u0.pm, tid); }
                pg8::EpiRes E{ws, mod + (size_t)l * 3 * NMOD + (dn ? 5 : 2) * D, dn ? (l + 1 < DEPTH ? 2 * (l + 1) : -1) : 2 * l + 1, (PG8_LAS float*)(lds + 131072 + 1024)};
#ifdef PROBE_DUP
                if (ph2 & 1) E.ninst = -2;
#endif
                SK3(pg8::gemm_phase<pg8::EpiRes, pg8::StaticOrder, true, true>(lds, g, S, E));
            } else {
                pg8::Gemm g{(const pg8::bf16_t*)(ws + WS_H), (const pg8::bf16_t*)(ws + WS_WUP) + (size_t)l * NUP * D, M, NUP, D};
                pg8::StaticOrder S; S.init(M, NUP, G, bx);
                pg8::EpiConv E{ws, ain(a, I_CW) + (size_t)l * 3 * NUP, ain(a, I_CB) + (size_t)l * NUP, (PG8_LAS float*)(lds + 131072 + 1024), l};
                SK4(pg8::gemm_phase<pg8::EpiConv, pg8::StaticOrder, true, true>(lds, g, S, E));
                if (defer && bx >= 32 && l + 1 < DEPTH) {
                    TIDS(); const int iw = (bx - 32) * NWAVES + wave, NIW = (G - 32) * NWAVES;
                    convert_layer(a, ws, lds, iw, NIW, lane, wave, l + 1, 1);
                }
            }
        }
#ifdef PROBE_DUP
        if (ph2 + 1 < 2 * a.ph_hi) {
#else
        if (ph + 1 < a.ph_hi) {
#endif: the first one is cg grid.sync() (marks the kernel cooperative for the replay), the rest the XCD-aware barrier
            if (a.ph_hi < 0) grid.sync();
            xcd_barrier(xbar);
#ifdef PROBE_SYNC2
            xcd_barrier(xbar);
#endif
        }
    }
}

#ifndef MK_MULTI
#define MK_MULTI 0
#endif
extern "C" void kernel_launch(void* const* d_in, const int* in_sizes, int n_in, void* d_out, int out_size, void* d_ws, size_t ws_size, hipStream_t stream) {
    static int grid = 0;
    if (grid == 0) {
        if (n_in != 21 || ws_size < WS_END) { fprintf(stderr, "kernel_launch: unexpected n_in %d / ws_size %zu\n", n_in, ws_size); grid = -1; return; }
        int dev = 0, cus = 0, per_cu = 0;
        hipGetDevice(&dev); hipDeviceGetAttribute(&cus, hipDeviceAttributeMultiprocessorCount, dev);
        if (hipFuncSetAttribute((const void*)mega_fwd, hipFuncAttributeMaxDynamicSharedMemorySize, LDS_BYTES) != hipSuccess) { fprintf(stderr, "kernel_launch: hipFuncSetAttribute failed\n"); grid = -1; return; }
        if (hipOccupancyMaxActiveBlocksPerMultiprocessor(&per_cu, (const void*)mega_fwd, NTHR, LDS_BYTES) != hipSuccess || per_cu < 1) { fprintf(stderr, "kernel_launch: occupancy query says %d\n", per_cu); (void)hipGetLastError(); grid = -1; return; }
        grid = cus * per_cu;
        fprintf(stderr, "kernel_launch: grid %d (cus %d x %d)\n", grid, cus, per_cu);
    }
    if (grid < 0) return;
    Args a{};
    for (int i = 0; i < 21; ++i) a.in[i] = (const float*)d_in[i];
    a.out = (float*)d_out; a.ws = (unsigned char*)d_ws;
#if MK_MULTI
    for (int ph = 0; ph < NPHASE; ++ph) { a.ph_lo = ph; a.ph_hi = ph + 1; hipLaunchKernelGGL(mega_fwd, dim3(grid), dim3(NTHR), LDS_BYTES, stream, a); }
#else
    a.ph_lo = 0; a.ph_hi = NPHASE;
    if (hipMemsetAsync(d_ws, 0, 16384, stream) != hipSuccess) { fprintf(stderr, "kernel_launch: memset failed\n"); return; }
    void* args[] = {&a};
    hipError_t e = hipLaunchCooperativeKernel((const void*)mega_fwd, dim3(grid), dim3(NTHR), args, LDS_BYTES, stream);
    if (e != hipSuccess) fprintf(stderr, "cooperative launch failed: %s (grid %d)\n", hipGetErrorString(e), grid);
#endif
}
```
